# Optimizing an MI355X kernel written in HIP

```python
import math
import jax, jax.numpy as jnp
from jax import lax
import numpy as np

D_MODEL = 1024
BATCH = 8
SEQ = 2048
DEPTH = 2

HEAD_DIM = 64
ATTN_WIDTH = D_MODEL // 2
ATTN_HEADS = ATTN_WIDTH // HEAD_DIM
KV_HEADS = 2
GROUP = ATTN_HEADS // KV_HEADS
IDX_HEADS = 16
IDX_DIM = 64
INDEX_TOPK = 256
Q_BLOCK = 128
CONV_WIDTH = D_MODEL // 4
CONV_KERNEL = 31
POOL_WIDTH = D_MODEL // 4
POOL_GROUPS = 4
POOL_GROUP_DIM = POOL_WIDTH // POOL_GROUPS
POOL_WINDOWS = (2, 4, 8, 16)
POOL_PAD = max(POOL_WINDOWS)
MIX_WIDTH = ATTN_WIDTH + CONV_WIDTH + POOL_WIDTH
D_FF = 4 * D_MODEL
PLE_DIM = 256
ROPE_THETA = 500000.0
ROPE_DIM = HEAD_DIM // 4
MAX_POS_OFFSET = 1024
NORM_EPS = 1e-6
LN_EPS = 1e-5

IN_SIZES = (
    ATTN_WIDTH,
    KV_HEADS * HEAD_DIM,
    KV_HEADS * HEAD_DIM,
    IDX_HEADS * IDX_DIM,
    IDX_DIM,
    IDX_HEADS,
    2 * CONV_WIDTH,
    POOL_WIDTH,
)
IN_WIDTH = int(sum(IN_SIZES))
IN_SPLITS = [int(v) for v in np.cumsum(IN_SIZES)[:-1]]

kernel_name = "hybrid_dsa_conformer_pool_block"


def rmsnorm(x, g):
    xf = x.astype(jnp.float32)
    y = xf * lax.rsqrt(jnp.mean(xf * xf, axis=-1, keepdims=True) + NORM_EPS)
    return (y * g.astype(jnp.float32)).astype(x.dtype)


def layernorm(x, g, b):
    xf = x.astype(jnp.float32)
    mu = jnp.mean(xf, axis=-1, keepdims=True)
    var = jnp.mean(jnp.square(xf - mu), axis=-1, keepdims=True)
    y = (xf - mu) * lax.rsqrt(var + LN_EPS)
    return (y * g.astype(jnp.float32) + b.astype(jnp.float32)).astype(x.dtype)


def rope_tables(positions):
    inv_freq = ROPE_THETA ** (-jnp.arange(0, ROPE_DIM, 2, dtype=jnp.float32) / ROPE_DIM)
    ang = positions.astype(jnp.float32)[..., None] * inv_freq
    return jnp.cos(ang)[:, :, None, :], jnp.sin(ang)[:, :, None, :]


def partial_rope(x, cos, sin):
    half = ROPE_DIM // 2
    cos = cos.astype(x.dtype)
    sin = sin.astype(x.dtype)
    x1 = x[..., :half]
    x2 = x[..., half:ROPE_DIM]
    return jnp.concatenate([x1 * cos - x2 * sin, x2 * cos + x1 * sin, x[..., ROPE_DIM:]], axis=-1)


def dsa_sparse_attention(q, k, v, qi, ki, wi):
    B, S = q.shape[0], q.shape[1]
    n_blk = S // Q_BLOCK
    k_sel = min(INDEX_TOPK, S // 4)
    idx_scale = (IDX_DIM ** -0.5) * (IDX_HEADS ** -0.5)
    att_scale = HEAD_DIM ** -0.5
    neg = jnp.finfo(jnp.float32).min
    key_pos = jnp.arange(S)
    b_idx = jnp.arange(B)[:, None, None]
    ki_f = ki.astype(jnp.float32)

    def to_blocks(t):
        return jnp.moveaxis(t.reshape((B, n_blk, Q_BLOCK) + t.shape[2:]), 1, 0)

    q_b = to_blocks(q.reshape(B, S, KV_HEADS, GROUP, HEAD_DIM))
    qi_b = to_blocks(qi)
    wi_b = to_blocks(wi)
    t_b = key_pos.reshape(n_blk, Q_BLOCK)

    def block(args):
        q_blk, qi_blk, wi_blk, t_blk = args
        dots = jnp.einsum('bthd,bsd->bths', qi_blk.astype(jnp.float32), ki_f)
        idx = jnp.einsum('bths,bth->bts', jax.nn.relu(dots), wi_blk.astype(jnp.float32)) * idx_scale
        causal = key_pos[None, :] <= t_blk[:, None]
        idx = jnp.where(causal[None], idx, -jnp.inf)
        _, sel = lax.top_k(idx, k_sel)
        valid = sel <= t_blk[None, :, None]
        k_g = k[b_idx, sel]
        v_g = v[b_idx, sel]
        s = jnp.einsum('bthgd,btnhd->bthgn', q_blk, k_g).astype(jnp.float32) * att_scale
        s = jnp.where(valid[:, :, None, None, :], s, neg)
        pr = jax.nn.softmax(s, axis=-1).astype(v.dtype)
        o = jnp.einsum('bthgn,btnhd->bthgd', pr, v_g)
        return o.reshape(B, Q_BLOCK, ATTN_WIDTH)

    out = lax.map(block, (q_b, qi_b, wi_b, t_b))
    return jnp.moveaxis(out, 0, 1).reshape(B, S, ATTN_WIDTH)


def conformer_conv(u, conv_dw, conv_b, ln_g, ln_b, conv_pw):
    a, g = jnp.split(u, 2, axis=-1)
    y = a * jax.nn.sigmoid(g)
    y = lax.conv_general_dilated(
        y, conv_dw[:, None, :], window_strides=(1,), padding=[(CONV_KERNEL - 1, 0)],
        dimension_numbers=('NWC', 'WIO', 'NWC'), feature_group_count=CONV_WIDTH)
    y = y + conv_b
    y = jax.nn.silu(layernorm(y, ln_g, ln_b))
    return jnp.einsum('bsc,cd->bsd', y, conv_pw)


def multiscale_pool(u, pool_w, pool_scale):
    B, S, _ = u.shape
    uf = u.astype(jnp.float32)
    c = jnp.cumsum(uf, axis=1)
    c_pad = jnp.concatenate([jnp.zeros((B, POOL_PAD, POOL_WIDTH), jnp.float32), c], axis=1)
    t = jnp.arange(S)
    outs = []
    for gi, w in enumerate(POOL_WINDOWS):
        sl = slice(gi * POOL_GROUP_DIM, (gi + 1) * POOL_GROUP_DIM)
        win_sum = c[:, :, sl] - c_pad[:, POOL_PAD - w:POOL_PAD - w + S, sl]
        count = jnp.minimum(t + 1, w).astype(jnp.float32)[None, :, None]
        outs.append(win_sum / count - uf[:, :, sl])
    y = jnp.stack(outs, axis=2).astype(u.dtype)
    y = jnp.einsum('bsgc,gcd->bsgd', y, pool_w).reshape(B, S, POOL_WIDTH)
    return y * pool_scale


def setup_inputs(seed: int = 0) -> dict:
    key = jax.random.key(seed)
    ks = jax.random.split(key, 24)
    nrm = jax.random.normal
    f32 = jnp.float32
    L = DEPTH
    x = nrm(ks[0], (BATCH, SEQ, D_MODEL), f32)
    p = nrm(ks[1], (DEPTH, BATCH, SEQ, PLE_DIM), f32)
    offs = jax.random.randint(ks[2], (BATCH, 1), 0, MAX_POS_OFFSET, dtype=jnp.int32)
    positions = (offs + jnp.arange(SEQ, dtype=jnp.int32)[None, :]).astype(jnp.int32)
    return {
        "x": x,
        "p": p,
        "positions": positions,
        "norm_mix_pre": 1.0 + 0.1 * nrm(ks[3], (L, D_MODEL), f32),
        "w_in": nrm(ks[4], (L, D_MODEL, IN_WIDTH), f32) * D_MODEL ** -0.5,
        "conv_dw": nrm(ks[5], (L, CONV_KERNEL, CONV_WIDTH), f32) * CONV_KERNEL ** -0.5,
        "conv_b": 0.02 * nrm(ks[6], (L, CONV_WIDTH), f32),
        "conv_ln_g": 1.0 + 0.1 * nrm(ks[7], (L, CONV_WIDTH), f32),
        "conv_ln_b": 0.02 * nrm(ks[8], (L, CONV_WIDTH), f32),
        "conv_pw": nrm(ks[9], (L, CONV_WIDTH, CONV_WIDTH), f32) * CONV_WIDTH ** -0.5,
        "pool_w": nrm(ks[10], (L, POOL_GROUPS, POOL_GROUP_DIM, POOL_GROUP_DIM), f32) * POOL_GROUP_DIM ** -0.5,
        "pool_scale": 1.0 + 0.1 * nrm(ks[11], (L, POOL_WIDTH), f32),
        "w_out": nrm(ks[12], (L, MIX_WIDTH, D_MODEL), f32) * MIX_WIDTH ** -0.5,
        "norm_mix_post": 1.0 + 0.1 * nrm(ks[13], (L, D_MODEL), f32),
        "norm_mlp_pre": 1.0 + 0.1 * nrm(ks[14], (L, D_MODEL), f32),
        "w_up": nrm(ks[15], (L, D_MODEL, D_FF), f32) * D_MODEL ** -0.5,
        "w_down": nrm(ks[16], (L, D_FF, D_MODEL), f32) * D_FF ** -0.5,
        "norm_mlp_post": 1.0 + 0.1 * nrm(ks[17], (L, D_MODEL), f32),
        "ple_proj": nrm(ks[18], (L, PLE_DIM, D_MODEL), f32) * PLE_DIM ** -0.5,
        "ple_gate": nrm(ks[19], (L, D_MODEL, D_MODEL), f32) * D_MODEL ** -0.5,
    }


def reference(x, p, positions, norm_mix_pre, w_in, conv_dw, conv_b, conv_ln_g, conv_ln_b,
              conv_pw, pool_w, pool_scale, w_out, norm_mix_post, norm_mlp_pre, w_up, w_down,
              norm_mlp_post, ple_proj, ple_gate):
    B, S, _ = x.shape
    cos, sin = rope_tables(positions)
    h = x
    for i in range(DEPTH):
        a = rmsnorm(h, norm_mix_pre[i])
        u = jnp.einsum('bsd,de->bse', a, w_in[i])
        q, k, v, qi, ki, wi, u_conv, u_pool = jnp.split(u, IN_SPLITS, axis=-1)
        q = partial_rope(q.reshape(B, S, ATTN_HEADS, HEAD_DIM), cos, sin)
        k = partial_rope(k.reshape(B, S, KV_HEADS, HEAD_DIM), cos, sin)
        v = v.reshape(B, S, KV_HEADS, HEAD_DIM)
        qi = partial_rope(qi.reshape(B, S, IDX_HEADS, IDX_DIM), cos, sin)
        ki = partial_rope(ki[:, :, None, :], cos, sin)[:, :, 0, :]
        y_attn = dsa_sparse_attention(q, k, v, qi, ki, wi)
        y_conv = conformer_conv(u_conv, conv_dw[i], conv_b[i], conv_ln_g[i],
                                conv_ln_b[i], conv_pw[i])
        y_pool = multiscale_pool(u_pool, pool_w[i], pool_scale[i])
        mix = jnp.concatenate([y_attn, y_conv, y_pool], axis=-1)
        mix = jnp.einsum('bse,ed->bsd', mix, w_out[i])
        h = h + rmsnorm(mix, norm_mix_post[i])
        m = rmsnorm(h, norm_mlp_pre[i])
        m = jnp.square(jax.nn.relu(jnp.einsum('bsd,df->bsf', m, w_up[i])))
        m = jnp.einsum('bsf,fd->bsd', m, w_down[i])
        h = h + rmsnorm(m, norm_mlp_post[i])
        gate = jax.nn.sigmoid(jnp.einsum('bsd,de->bse', h, ple_gate[i]))
        h = h + gate * jnp.einsum('bsp,pd->bsd', p[i], ple_proj[i])
    return h
```

```cpp
#include <hip/hip_runtime.h>
#include <cstdio>
#include <cstdint>
#ifndef DBG_SELECT_ALL
#define DBG_SELECT_ALL 0
#endif
namespace pg8 {
#define PG8_LAS __attribute__((address_space(3)))
typedef unsigned short bf16_t;
typedef short bf16x8 __attribute__((ext_vector_type(8)));
typedef float f32x4 __attribute__((ext_vector_type(4)));
typedef unsigned u32x4 __attribute__((ext_vector_type(4)));
constexpr int BM = 256, BK = 64, HALF = 128, HTB = HALF * BK * 2  , STAGE_BYTES = 8 * HTB, NXCD = 8, WGM = 8;

__host__ __device__ __forceinline__ int lds_byte(int r, int c) { const int st = (r >> 4) * 2 + (c >> 5), rr = r & 15, cc = c & 31, ob = rr * 64 + cc * 2; return st * 1024 + (ob ^ (((ob >> 9) & 1) << 5)); }
__host__ __device__ __forceinline__ void stage_rc(int b, int& R, int& C) { const int st = b / 1024, sb = b % 1024, swz = sb ^ (((sb >> 9) & 1) << 5); R = (st >> 1) * 16 + swz / 64; C = (st & 1) * 32 + (swz % 64) / 2; }
__host__ __device__ __forceinline__ int perm32(int rho) { const int n = rho >> 4, i = rho & 15; return 8 * (i >> 2) + 4 * n + (i & 3); }

struct Unit { int pm, pn; };
struct Gemm { const bf16_t* A; const bf16_t* Bt; int M, N, K; };

struct StaticOrder {
    int nM, nN, nwg, G, c;
    __host__ __device__ void init(int M, int N, int G_, int c_) { nM = M / BM; nN = N / BM; nwg = nM * nN; G = G_; c = c_; }
    __host__ __device__ bool next(int i, Unit& u) const {
        const long L = (long)i * G + c; if (L >= nwg) return false;
        int wgid = (int)L; { const int q = nwg / NXCD, r = nwg % NXCD, xcd = wgid % NXCD, off = wgid / NXCD; wgid = (xcd < r ? xcd * (q + 1) : r * (q + 1) + (xcd - r) * q) + off; }
        const int nig = WGM * nN, gid = wgid / nig, fm = gid * WGM, gsz = (nM - fm) < WGM ? (nM - fm) : WGM;
        u.pm = fm + ((wgid % nig) % gsz); u.pn = (wgid % nig) / gsz; return true;
    }
    __device__ __forceinline__ void a_ready(const Unit&) const {}
    __device__ __forceinline__ void done(const Unit&) const {}
};

__device__ __forceinline__ unsigned cvt_pk_bf16(float lo, float hi) { unsigned r; asm volatile("v_cvt_pk_bf16_f32 %0, %1, %2" : "=v"(r) : "v"(lo), "v"(hi)); return r; }
typedef float f32x2 __attribute__((ext_vector_type(2)));
typedef _Float16 half_t;
typedef _Float16 half8 __attribute__((ext_vector_type(8)));
typedef _Float16 half4 __attribute__((ext_vector_type(4)));
typedef float f32x8 __attribute__((ext_vector_type(8)));
typedef float f32x16 __attribute__((ext_vector_type(16)));

template <int ACT> struct EpiBf16 {
    static constexpr bool PERM = true, AFTER_DRAIN = false;
    bf16_t* O; int ldc;
    __device__ __forceinline__ void operator()(const f32x4 (&acc)[2][2][4][2], const Unit& u, int wr, int wc, int fr, int fq) const {
        asm volatile("" : "+v"(fr));
        const int row0 = u.pm * BM + wr * 64 + fr, col0 = u.pn * BM + wc * 32 + 8 * fq;
#pragma unroll
        for (int ai = 0; ai < 2; ++ai)
#pragma unroll
            for (int m = 0; m < 4; ++m) { bf16_t* rowp = O + (size_t)(row0 + ai * HALF + m * 16) * ldc + col0;
#pragma unroll
                for (int bj = 0; bj < 2; ++bj) { f32x4 v0 = acc[ai][bj][m][0], v1 = acc[ai][bj][m][1];
                    if (ACT == 1) {
#pragma unroll
                        for (int e = 0; e < 4; ++e) { const float a = fmaxf(v0[e], 0.f), b = fmaxf(v1[e], 0.f); v0[e] = a * a; v1[e] = b * b; } }
                    u32x4 w; w.x = cvt_pk_bf16(v0[0], v0[1]); w.y = cvt_pk_bf16(v0[2], v0[3]); w.z = cvt_pk_bf16(v1[0], v1[1]); w.w = cvt_pk_bf16(v1[2], v1[3]);
                    *(u32x4*)(rowp + bj * HALF) = w; } }
    }
};

struct EpiGate {
    static constexpr bool PERM = true, AFTER_DRAIN = false;
    float* H; const bf16_t* PLE;
    __device__ __forceinline__ void operator()(const f32x4 (&acc)[2][2][4][2], const Unit& u, int wr, int wc, int fr, int fq) const {
        asm volatile("" : "+v"(fr));
        const int row0 = u.pm * BM + wr * 64 + fr, col0 = u.pn * BM + wc * 32 + 8 * fq;
#pragma unroll
        for (int ai = 0; ai < 2; ++ai)
#pragma unroll
            for (int m = 0; m < 4; ++m) { const size_t ro = (size_t)(row0 + ai * HALF + m * 16) * 1024 + col0;
#pragma unroll
                for (int bj = 0; bj < 2; ++bj) { const size_t off = ro + bj * HALF;
                    const u32x4 pw = *(const u32x4*)(PLE + off);
                    f32x4 h0 = *(const f32x4*)(H + off), h1 = *(const f32x4*)(H + off + 4);
                    const f32x4 a0 = acc[ai][bj][m][0], a1 = acc[ai][bj][m][1];
                    float pl[8];
#pragma unroll
                    for (int e = 0; e < 4; ++e) { pl[2 * e] = __uint_as_float(pw[e] << 16); pl[2 * e + 1] = __uint_as_float(pw[e] & 0xffff0000u); }
#pragma unroll
                    for (int e = 0; e < 4; ++e) {
                        const float g0 = __builtin_amdgcn_rcpf(1.f + __builtin_amdgcn_exp2f(-1.4426950408889634f * a0[e]));
                        const float g1 = __builtin_amdgcn_rcpf(1.f + __builtin_amdgcn_exp2f(-1.4426950408889634f * a1[e]));
                        h0[e] += g0 * pl[e]; h1[e] += g1 * pl[4 + e]; }
                    *(f32x4*)(H + off) = h0; *(f32x4*)(H + off + 4) = h1; }
                asm volatile("" ::: "memory"); }
    }
};

struct EpiIn {
    static constexpr bool PERM = true, AFTER_DRAIN = false;
    half_t* Q; half_t* KB; half_t* VT; half_t* QI; u32x4* KI; float* WI; half_t* UC; half_t* UP; const float* ROPE; float qscale;
    __device__ __forceinline__ void operator()(const f32x4 (&acc)[2][2][4][2], const Unit& u, int wr, int wc, int fr, int fq) const {
        asm volatile("" : "+v"(fr));
        const int pn = u.pn;
        const bool ropew = ((pn <= 6) || (pn == 10)) && ((wc & 1) == 0);
#pragma unroll
        for (int ai = 0; ai < 2; ++ai)
#pragma unroll
            for (int m = 0; m < 4; ++m) {
                const int row = u.pm * BM + ai * HALF + wr * 64 + m * 16 + fr;
                const int bb = row >> 11, tt = row & 2047;
                f32x4 cs0 = {1.f, 1.f, 1.f, 1.f}, cs1 = cs0, sn0 = {0.f, 0.f, 0.f, 0.f}, sn1 = sn0;
                if (ropew) { const f32x4* rp = (const f32x4*)(ROPE + (size_t)row * 16); cs0 = rp[0]; cs1 = rp[1]; sn0 = rp[2]; sn1 = rp[3]; }
#pragma unroll
                for (int bj = 0; bj < 2; ++bj) {
                    float v[8];
#pragma unroll
                    for (int e = 0; e < 4; ++e) { v[e] = acc[ai][bj][m][0][e]; v[4 + e] = acc[ai][bj][m][1][e]; }
                    const bool rp_here = ropew && !(pn == 2 && bj == 1) && !(pn == 10 && (bj == 1 || wc != 0));
                    if (rp_here) {
#pragma unroll
                        for (int e = 0; e < 8; ++e) {
                            const float oth = __shfl_xor(v[e], 16);
                            const float c = e < 4 ? cs0[e & 3] : cs1[e & 3], s = e < 4 ? sn0[e & 3] : sn1[e & 3];
                            const float res = v[e] * c + (fq == 0 ? -oth : oth) * s;
                            if (fq < 2) v[e] = res;
                        }
                    }
                    const int tc = bj * HALF + wc * 32 + fq * 8;
                    if (pn < 2) {
                        half8 h;
#pragma unroll
                        for (int e = 0; e < 8; ++e) h[e] = (half_t)(v[e] * qscale);
                        *(half8*)(Q + (size_t)row * 512 + pn * 256 + tc) = h;
                    } else if (pn == 2) {
                        if (bj == 0) { half8 h;
#pragma unroll
                            for (int e = 0; e < 8; ++e) h[e] = (half_t)v[e];
                            *(half8*)(KB + (size_t)row * 128 + tc) = h;
                        } else { const int vcol = tc - 128, kvh = vcol >> 6, d0 = vcol & 63;
                            half_t* vb = VT + ((size_t)((bb * 2 + kvh) * 64 + d0) * 2048 + tt);
#pragma unroll
                            for (int e = 0; e < 8; ++e) vb[(size_t)e * 2048] = (half_t)v[e];
                        }
                    } else if (pn < 7) { half8 h;
#pragma unroll
                        for (int e = 0; e < 8; ++e) h[e] = (half_t)v[e];
                        *(half8*)(QI + (size_t)row * 1024 + (pn - 3) * 256 + tc) = h;
                    } else if (pn < 9) { half8 h;
#pragma unroll
                        for (int e = 0; e < 8; ++e) h[e] = (half_t)v[e];
                        *(half8*)(UC + (size_t)row * 512 + (pn - 7) * 256 + tc) = h;
                    } else if (pn == 9) { half8 h;
#pragma unroll
                        for (int e = 0; e < 8; ++e) h[e] = (half_t)v[e];
                        *(half8*)(UP + (size_t)row * 256 + tc) = h;
                    } else {
                        if (bj == 0) {
                            if (wc < 2) { half8 h;
#pragma unroll
                                for (int e = 0; e < 8; ++e) h[e] = (half_t)v[e];
                                const int c = wc * 4 + fq;
                                KI[((size_t)((bb * 16 + (tt >> 7)) * 8 + c)) * 128 + (tt & 127)] = __builtin_bit_cast(u32x4, h);
                            } else if (wc == 2 && fq < 2) {
                                float* wp = WI + (size_t)row * 16 + fq * 8;
                                *(f32x4*)wp = (f32x4){v[0], v[1], v[2], v[3]}; *(f32x4*)(wp + 4) = (f32x4){v[4], v[5], v[6], v[7]};
                            }
                        }
                    }
                }
                asm volatile("" ::: "memory");
            }
    }
};


template <class Epi, class Sched, bool ALIGN_EPI = false, bool SP2 = false>
__device__ __forceinline__ void gemm_phase(PG8_LAS unsigned char* lds, const Gemm g, const Sched& S, const Epi& E) {
    int tid = threadIdx.x; asm volatile("" : "+v"(tid));
    const int wid = __builtin_amdgcn_readfirstlane(tid >> 6), lane = tid & 63, wr = wid >> 2, wc = wid & 3, fr = lane & 15, fq = lane >> 4;
    const int K = g.K, nt = K / BK;
    unsigned voffA[2], voffB[2];
#pragma unroll
    for (int i = 0; i < 2; ++i) { int R, C; stage_rc(tid * 16 + i * 8192, R, C); const int Rb = Epi::PERM ? ((R & ~31) + perm32(R & 31)) : R;
        voffA[i] = (unsigned)(R * K + C) * 2u; voffB[i] = (unsigned)(Rb * K + C) * 2u; }
    const size_t kstep = (size_t)(BK * 2);
    const size_t hstep = (size_t)HALF * K * 2;
    const size_t tstep = 2 * hstep;
    const unsigned ldsw = (unsigned)wid * 1024u;
    const int aoff = lds_byte(wr * 64 + fr, fq * 8), boff = lds_byte(wc * 32 + fr, fq * 8);
#define PG8_SA(b, h) (((b) * 2 + (h)) * HTB)
#define PG8_SB(b, h) ((4 + (b) * 2 + (h)) * HTB)
#define PG8_STAGE(bufoff, gbase, voff) do { _Pragma("unroll") for (int _i = 0; _i < 2; ++_i) \
        __builtin_amdgcn_global_load_lds((const unsigned*)((const char*)(gbase) + (voff)[_i]), (PG8_LAS unsigned*)(lds + (bufoff) + ldsw + _i * 8192), 16, 0, 0); } while (0)
#define PG8_LDA(dst, b, h) do { _Pragma("unroll") for (int m = 0; m < 4; ++m) _Pragma("unroll") for (int k = 0; k < 2; ++k) dst[m][k] = *(const PG8_LAS bf16x8*)(lds + PG8_SA(b, h) + aoff + m * 2048 + k * 1024); } while (0)
#define PG8_LDB(dst, b, h) do { _Pragma("unroll") for (int n = 0; n < 2; ++n) _Pragma("unroll") for (int k = 0; k < 2; ++k) dst[n][k] = *(const PG8_LAS bf16x8*)(lds + PG8_SB(b, h) + boff + n * 2048 + k * 1024); } while (0)
#define PG8_MMA(ai, bj, At, Bt) do { __builtin_amdgcn_s_setprio(1); _Pragma("unroll") for (int m = 0; m < 4; ++m) _Pragma("unroll") for (int n = 0; n < 2; ++n) _Pragma("unroll") for (int k = 0; k < 2; ++k) \
        acc[ai][bj][m][n] = __builtin_amdgcn_mfma_f32_16x16x32_bf16(Bt[n][k], At[m][k], acc[ai][bj][m][n], 0, 0, 0); __builtin_amdgcn_s_setprio(0); } while (0)
#define PG8_WAIT_V(n) asm volatile("s_waitcnt vmcnt(" #n ")" ::: "memory")
#define PG8_WAIT_L(n) asm volatile("s_waitcnt lgkmcnt(" #n ")" ::: "memory")
#define PG8_BAR __builtin_amdgcn_s_barrier()
#define PG8_SCHED __builtin_amdgcn_sched_barrier(0)
    Unit cur, nxt; int ui = 0;
    if (!S.next(0, cur)) return;
    f32x4 acc[2][2][4][2];
#pragma unroll
    for (int a = 0; a < 2; ++a)
#pragma unroll
        for (int b = 0; b < 2; ++b)
#pragma unroll
            for (int m = 0; m < 4; ++m)
#pragma unroll
                for (int n = 0; n < 2; ++n) acc[a][b][m][n] = (f32x4){0.f, 0.f, 0.f, 0.f};
    bf16x8 At[4][2], B0[2][2], B1[2][2];
    const char* cA = (const char*)g.A + (size_t)cur.pm * tstep; const char* cB = (const char*)g.Bt + (size_t)cur.pn * tstep;
    S.a_ready(cur);
    if constexpr (SP2) {
        PG8_STAGE(PG8_SB(0, 0), cB, voffB); PG8_STAGE(PG8_SB(0, 1), cB + hstep, voffB); PG8_STAGE(PG8_SA(0, 0), cA, voffA); PG8_STAGE(PG8_SA(0, 1), cA + hstep, voffA);
        if (wr == 1) PG8_BAR;
        PG8_WAIT_V(2); PG8_BAR;
        PG8_STAGE(PG8_SB(1, 0), cB + kstep, voffB); PG8_STAGE(PG8_SA(1, 0), cA + kstep, voffA); PG8_STAGE(PG8_SB(1, 1), cB + hstep + kstep, voffB);
        PG8_WAIT_V(6); PG8_BAR;
    } else {
        PG8_STAGE(PG8_SB(0, 0), cB, voffB); PG8_STAGE(PG8_SA(0, 0), cA, voffA); PG8_STAGE(PG8_SB(0, 1), cB + hstep, voffB); PG8_STAGE(PG8_SA(0, 1), cA + hstep, voffA);
        if (wr == 1) PG8_BAR;
        PG8_WAIT_V(4); PG8_BAR;
        PG8_STAGE(PG8_SB(1, 0), cB + kstep, voffB); PG8_STAGE(PG8_SA(1, 0), cA + kstep, voffA); PG8_STAGE(PG8_SB(1, 1), cB + hstep + kstep, voffB);
        PG8_WAIT_V(6); PG8_BAR;
    }
    for (;;) {
        const bool has_next = S.next(ui + 1, nxt);
        const char* nA = has_next ? (const char*)g.A + (size_t)nxt.pm * tstep : cA; const char* nB = has_next ? (const char*)g.Bt + (size_t)nxt.pn * tstep : cB;
        for (int t = 0; t < nt; t += 2) {
            const bool last = (t == nt - 2);
            const char* a1 = cA + (size_t)(t + 1) * kstep;
            const char* a2 = last ? nA : cA + (size_t)(t + 2) * kstep; const char* b2 = last ? nB : cB + (size_t)(t + 2) * kstep;
            const char* a3 = a2 + kstep; const char* b3 = b2 + kstep;
            if (last && has_next) S.a_ready(nxt);
            if constexpr (SP2) {
            PG8_LDB(B0, 0, 0); PG8_LDB(B1, 0, 1); PG8_SCHED; PG8_LDA(At, 0, 0); PG8_STAGE(PG8_SA(1, 1), a1 + hstep, voffA);
            PG8_WAIT_V(8); PG8_WAIT_L(0); PG8_BAR; PG8_MMA(0, 0, At, B0); PG8_MMA(0, 1, At, B1); PG8_BAR; PG8_SCHED;
            PG8_LDA(At, 0, 1); PG8_STAGE(PG8_SB(0, 0), b2, voffB); PG8_STAGE(PG8_SB(0, 1), b2 + hstep, voffB); PG8_STAGE(PG8_SA(0, 0), a2, voffA);
            PG8_WAIT_V(8); PG8_WAIT_L(0); PG8_BAR; PG8_MMA(1, 0, At, B0); PG8_MMA(1, 1, At, B1); PG8_BAR; PG8_SCHED;
            PG8_LDB(B0, 1, 0); PG8_LDB(B1, 1, 1); PG8_SCHED; PG8_LDA(At, 1, 0); PG8_STAGE(PG8_SA(0, 1), a2 + hstep, voffA);
            PG8_WAIT_V(8); PG8_WAIT_L(0); PG8_BAR; PG8_MMA(0, 0, At, B0); PG8_MMA(0, 1, At, B1); PG8_BAR; PG8_SCHED;
            PG8_LDA(At, 1, 1); PG8_STAGE(PG8_SB(1, 0), b3, voffB); PG8_STAGE(PG8_SB(1, 1), b3 + hstep, voffB); PG8_STAGE(PG8_SA(1, 0), a3, voffA);
            PG8_WAIT_V(8); PG8_WAIT_L(0); PG8_BAR; PG8_MMA(1, 0, At, B0); PG8_MMA(1, 1, At, B1); PG8_BAR; PG8_SCHED;
            } else {
            PG8_LDB(B0, 0, 0); PG8_SCHED; PG8_LDA(At, 0, 0); PG8_STAGE(PG8_SA(1, 1), a1 + hstep, voffA);
            PG8_WAIT_L(8); PG8_BAR; PG8_WAIT_L(0); PG8_MMA(0, 0, At, B0); PG8_BAR; PG8_SCHED;
            PG8_LDB(B1, 0, 1); PG8_STAGE(PG8_SB(0, 0), b2, voffB);
            PG8_BAR; PG8_WAIT_L(0); PG8_MMA(0, 1, At, B1); PG8_BAR;
            PG8_LDA(At, 0, 1); PG8_STAGE(PG8_SA(0, 0), a2, voffA);
            PG8_BAR; PG8_WAIT_L(0); PG8_MMA(1, 0, At, B0); PG8_BAR; PG8_SCHED;
            PG8_STAGE(PG8_SB(0, 1), b2 + hstep, voffB);
            PG8_WAIT_V(6); PG8_BAR; PG8_MMA(1, 1, At, B1); PG8_BAR;
            PG8_LDB(B0, 1, 0); PG8_SCHED; PG8_LDA(At, 1, 0); PG8_STAGE(PG8_SA(0, 1), a2 + hstep, voffA);
            PG8_WAIT_L(8); PG8_BAR; PG8_WAIT_L(0); PG8_MMA(0, 0, At, B0); PG8_BAR; PG8_SCHED;
            PG8_LDB(B1, 1, 1); PG8_STAGE(PG8_SB(1, 0), b3, voffB);
            PG8_BAR; PG8_WAIT_L(0); PG8_MMA(0, 1, At, B1); PG8_BAR;
            PG8_LDA(At, 1, 1); PG8_STAGE(PG8_SA(1, 0), a3, voffA);
            PG8_BAR; PG8_WAIT_L(0); PG8_MMA(1, 0, At, B0); PG8_BAR; PG8_SCHED;
            PG8_STAGE(PG8_SB(1, 1), b3 + hstep, voffB);
            PG8_WAIT_V(6); PG8_BAR; PG8_MMA(1, 1, At, B1); PG8_BAR;
            }
        }
        if constexpr (ALIGN_EPI) { if (wr == 0) PG8_BAR; }
        if constexpr (!Epi::AFTER_DRAIN) { E(acc, cur, wr, wc, fr, fq); S.done(cur); }
        if (!has_next) break;
#pragma unroll
        for (int a = 0; a < 2; ++a)
#pragma unroll
            for (int b = 0; b < 2; ++b)
#pragma unroll
                for (int m = 0; m < 4; ++m)
#pragma unroll
                    for (int n = 0; n < 2; ++n) acc[a][b][m][n] = (f32x4){0.f, 0.f, 0.f, 0.f};
        cur = nxt; cA = nA; cB = nB; ++ui;
        if constexpr (ALIGN_EPI) { if (wr == 1) PG8_BAR; }
    }
    PG8_WAIT_V(0);
    if constexpr (!ALIGN_EPI) { if (wr == 0) PG8_BAR; }
    PG8_BAR;
    if constexpr (Epi::AFTER_DRAIN) { E.fused(acc, cur, wr, wc, fr, fq, lds, wid, lane); S.done(cur); }
#undef PG8_SA
#undef PG8_SB
#undef PG8_STAGE
#undef PG8_LDA
#undef PG8_LDB
#undef PG8_MMA
#undef PG8_WAIT_V
#undef PG8_WAIT_L
#undef PG8_BAR
#undef PG8_SCHED
}
}
#define GAS __attribute__((address_space(1)))
#define LAS __attribute__((address_space(3)))
typedef unsigned short bf16;
typedef unsigned v4u __attribute__((ext_vector_type(4)));
typedef float f32x4 __attribute__((ext_vector_type(4)));
typedef short bf16x8 __attribute__((ext_vector_type(8)));
typedef GAS unsigned gu32;
typedef GAS unsigned long long gu64;
#define RLX_AGENT __ATOMIC_RELAXED, __HIP_MEMORY_SCOPE_AGENT
#define LDS_WAIT() asm volatile("s_waitcnt lgkmcnt(0)" ::: "memory")
#define VM_WAIT() asm volatile("s_waitcnt vmcnt(0)" ::: "memory")
__device__ __forceinline__ unsigned long long rt() { return __builtin_amdgcn_s_memrealtime(); }
__device__ __forceinline__ unsigned f2bf(float f) { unsigned u = __builtin_bit_cast(unsigned, f); return (u + 0x7fffu + ((u >> 16) & 1u)) >> 16; }
__device__ __forceinline__ unsigned pk2(float lo, float hi) { return f2bf(lo) | (f2bf(hi) << 16); }

#define XB_TMO      128
#define XB_XCNT(j)  (256  + 64 * (j))
#define XB_XSUB(j)  (1280 + 64 * (j))
#define XB_XGEN(j)  (2304 + 64 * (j))
#define XB_TOP      3328
#define XB_TOPGEN   3392
#define XCD_BAR_WORDS 3456
#define XB_SPIN_CAP (1u << 18)

__device__ __forceinline__ unsigned xb_ld(unsigned* p)              { return __hip_atomic_load(p, __ATOMIC_RELAXED, __HIP_MEMORY_SCOPE_AGENT); }
__device__ __forceinline__ unsigned xb_add(unsigned* p, unsigned v) { return __hip_atomic_fetch_add(p, v, __ATOMIC_RELAXED, __HIP_MEMORY_SCOPE_AGENT); }
__device__ __forceinline__ unsigned xb_xcc_id() { return (unsigned)__builtin_amdgcn_s_getreg((3 << 11) | 20) & 0xFu; }
#define XB_SPIN(cond, bar) do { unsigned _sp = 0; while (cond) { __builtin_amdgcn_s_sleep(1); \
    if ((++_sp & 255u) == 0u) { if (xb_ld(&(bar)[XB_TMO])) break; if (_sp > XB_SPIN_CAP) { atomicAdd(&(bar)[XB_TMO], 1u); break; } } } } while (0)

struct XcdBarrier {
    unsigned* bar; unsigned x;
    volatile LAS unsigned* st;
};

__device__ __forceinline__ XcdBarrier xcd_barrier_post(unsigned* bar, volatile LAS unsigned* st) {
    XcdBarrier b; b.bar = bar; b.x = xb_xcc_id(); b.st = st;
    if (threadIdx.x == 0) (void)xb_add(&bar[XB_XCNT(b.x)], 1u);
    return b;
}
__device__ __forceinline__ void xcd_barrier_complete(unsigned* bar, unsigned x, unsigned& nloc, unsigned& nx) {
    const unsigned G = gridDim.x * gridDim.y * gridDim.z;
    unsigned sum, cnt, mine, sp = 0u;
    for (;;) {
        sum = 0u; cnt = 0u; mine = 0u;
#pragma unroll
        for (unsigned j = 0; j < 16; ++j) { const unsigned c = xb_ld(&bar[XB_XCNT(j)]); sum += c; cnt += (c > 0u) ? 1u : 0u; mine = (j == x) ? c : mine; }
        if (sum == G) break;
        __builtin_amdgcn_s_sleep(1);
        if ((++sp & 255u) == 0u) { if (xb_ld(&bar[XB_TMO])) break; if (sp > XB_SPIN_CAP) { atomicAdd(&bar[XB_TMO], 1u); break; } }
    }
    nloc = mine > 0u ? mine : 1u; nx = cnt > 0u ? cnt : 1u;
}

__device__ __forceinline__ void xcd_barrier(const XcdBarrier& b) {
    asm volatile("s_waitcnt vmcnt(0)" ::: "memory");
    __syncthreads();
    if (threadIdx.x == 0) {
        unsigned* bar = b.bar;
        __builtin_amdgcn_s_waitcnt(0);
        unsigned nloc = b.st[0], nx = b.st[1];
        if (nloc == 0u) { xcd_barrier_complete(bar, b.x, nloc, nx); b.st[0] = nloc; b.st[1] = nx; }
        const unsigned old = xb_add(&bar[XB_XSUB(b.x)], 1u);
        const unsigned gen = old / nloc;
        if (old + 1u == (gen + 1u) * nloc) {
            __builtin_amdgcn_fence(__ATOMIC_RELEASE, "agent");
            asm volatile("s_waitcnt vmcnt(0)" ::: "memory");
            const unsigned og = xb_add(&bar[XB_TOP], 1u);
            const unsigned tg = og / nx;
            if (og + 1u == (tg + 1u) * nx) xb_add(&bar[XB_TOPGEN], 1u);
            else XB_SPIN(xb_ld(&bar[XB_TOPGEN]) == tg, bar);
            __builtin_amdgcn_fence(__ATOMIC_ACQUIRE, "agent");
            xb_add(&bar[XB_XGEN(b.x)], 1u);
            asm volatile("s_waitcnt vmcnt(0)" ::: "memory");
        } else {
            XB_SPIN(xb_ld(&bar[XB_XGEN(b.x)]) == gen, bar);
            __builtin_amdgcn_fence(__ATOMIC_ACQUIRE, "agent");
            asm volatile("s_waitcnt vmcnt(0)" ::: "memory");
        }
    }
    __syncthreads();
}

constexpr int NB = 8, SEQ = 2048, DM = 1024, FF = 4096, NLAYER = 2, PLE_DIM = 256, NIN = 2816;
constexpr int M = NB * SEQ;
constexpr float NORM_EPS = 1e-6f, LN_EPS = 1e-5f;
constexpr float QSCALE = 0.125f * 1.4426950408889634f;
constexpr int NWAVES = 8;
constexpr int PH_PER_LAYER = 9, NPHASE = NLAYER * PH_PER_LAYER;
#ifndef MK_N_LAUNCHES
#define MK_N_LAUNCHES 1
#endif
constexpr int N_LAUNCHES = MK_N_LAUNCHES;

constexpr size_t MiB = 1u << 20;
constexpr size_t WS_CTL = 0, CTL_ZERO_BYTES = 1 * MiB;
constexpr size_t WS_WIN = 1 * MiB, WS_WOUT = 7 * MiB, WS_WUP = 9 * MiB, WS_WDN = 17 * MiB, WS_WGATE = 25 * MiB, WS_WPLE = 27 * MiB, WS_WCPW = 27 * MiB + 512 * 1024, WS_WPOOL = 27 * MiB + 768 * 1024;
constexpr size_t WS_ROPE = 28 * MiB, WS_P = 29 * MiB, WS_XN = 37 * MiB, WS_Y = 69 * MiB, WS_BIG = 101 * MiB;
constexpr size_t WS_HD = WS_BIG;
constexpr size_t WS_Q = 101 * MiB, WS_QI = 117 * MiB, WS_UC = 149 * MiB, WS_UP = 165 * MiB, WS_KB = 173 * MiB, WS_VT = 177 * MiB, WS_KI = 181 * MiB, WS_WI = 183 * MiB, WS_MIX = 184 * MiB;
constexpr size_t WS_END = 229 * MiB;
static_assert(WS_WIN + (size_t)NIN * DM * 2 <= WS_WOUT && WS_MIX + (size_t)M * DM * 2 <= WS_END && WS_HD + (size_t)M * FF * 2 <= WS_END, "d_ws map");
constexpr int CW_TMO = 0, CW_CODE = 1, CW_BAR = 4096;
constexpr int RING_BYTES = 131072, LDSCTL_OFF = RING_BYTES, MISC_OFF = LDSCTL_OFF + 320, LDS_BYTES = 147456;

__device__ __forceinline__ float wave_sum(float v) {
#pragma unroll
    for (int o = 1; o < 64; o <<= 1) v += __shfl_xor(v, o);
    return v;
}
__device__ __forceinline__ float bf_lo(unsigned w) { return __uint_as_float(w << 16); }
__device__ __forceinline__ float bf_hi(unsigned w) { return __uint_as_float(w & 0xffff0000u); }
typedef unsigned u32x2 __attribute__((ext_vector_type(2)));
typedef _Float16 half_t;
typedef _Float16 half8 __attribute__((ext_vector_type(8)));
typedef _Float16 half4 __attribute__((ext_vector_type(4)));
typedef float f32x16 __attribute__((ext_vector_type(16)));

__device__ __forceinline__ void sincos_acc(float ang, float& c, float& s) {
    const double a = (double)ang;
    const double q = __builtin_rint(a * 0.63661977236758134308);
    const double r = (a - q * 1.57079632679489655800) - q * 6.12323399573676603587e-17;
    const int n = ((int)q) & 3;
    const double r2 = r * r;
    const double sp = r * (1.0 + r2 * (-1.0 / 6 + r2 * (1.0 / 120 + r2 * (-1.0 / 5040 + r2 * (1.0 / 362880 + r2 * (-1.0 / 39916800 + r2 * (1.0 / 6227020800.0)))))));
    const double cp = 1.0 + r2 * (-0.5 + r2 * (1.0 / 24 + r2 * (-1.0 / 720 + r2 * (1.0 / 40320 + r2 * (-1.0 / 3628800 + r2 * (1.0 / 479001600.0 + r2 * (-1.0 / 87178291200.0)))))));
    const double sv = (n == 0) ? sp : (n == 1) ? cp : (n == 2) ? -sp : -cp;
    const double cv = (n == 0) ? cp : (n == 1) ? -sp : (n == 2) ? -cp : sp;
    c = (float)cv; s = (float)sv;
}

__device__ __forceinline__ void tr_item(const float* W, int K, int N, int scol, int nvalid, bf16* WT, int drow, int k0, LAS float* scr, int lane) {
    const int n = lane & 31;
#pragma unroll 8
    for (int i = 0; i < 32; ++i) { const int kk = 2 * i + (lane >> 5); scr[kk * 33 + n] = (n < nvalid) ? W[(size_t)(k0 + kk) * N + scol + n] : 0.f; }
    LDS_WAIT(); asm volatile("" ::: "memory");
    const int c = lane & 7;
#pragma unroll
    for (int j = 0; j < 4; ++j) { const int nn = (lane >> 3) + 8 * j; const LAS float* s = scr + (8 * c) * 33 + nn;
        v4u o; o.x = pk2(s[0 * 33], s[1 * 33]); o.y = pk2(s[2 * 33], s[3 * 33]); o.z = pk2(s[4 * 33], s[5 * 33]); o.w = pk2(s[6 * 33], s[7 * 33]);
        *(GAS v4u*)(WT + (size_t)(drow + nn) * K + k0 + 8 * c) = o; }
    LDS_WAIT(); asm volatile("" ::: "memory");
}

__device__ __forceinline__ void t0_row(const float* src, float* dstcopy, const float* g, bf16* xn, int lane) {
    const f32x4* xr = (const f32x4*)src + lane;
    f32x4 v[4]; float s = 0.f;
#pragma unroll
    for (int j = 0; j < 4; ++j) { v[j] = xr[64 * j]; s += (v[j].x * v[j].x + v[j].y * v[j].y) + (v[j].z * v[j].z + v[j].w * v[j].w); }
    if (dstcopy) {
#pragma unroll
        for (int j = 0; j < 4; ++j) ((f32x4*)dstcopy + lane)[64 * j] = v[j]; }
    const float rs = 1.0f / sqrtf(wave_sum(s) * (1.f / DM) + NORM_EPS);
    unsigned long long* o8 = (unsigned long long*)xn + lane;
#pragma unroll
    for (int j = 0; j < 4; ++j) { const f32x4 gv = ((const f32x4*)g + lane)[64 * j];
        o8[64 * j] = (unsigned long long)pk2(v[j].x * rs * gv.x, v[j].y * rs * gv.y) | ((unsigned long long)pk2(v[j].z * rs * gv.z, v[j].w * rs * gv.w) << 32); }
}
__device__ __forceinline__ void tres_row(const bf16* y, const float* gpost, float* h, const float* gnext, bf16* xn, int lane) {
    f32x4 yv[4], hv[4]; float s = 0.f;
#pragma unroll
    for (int j = 0; j < 4; ++j) { const u32x2 w = ((const u32x2*)y)[lane + 64 * j]; yv[j] = (f32x4){bf_lo(w.x), bf_hi(w.x), bf_lo(w.y), bf_hi(w.y)};
        s += (yv[j].x * yv[j].x + yv[j].y * yv[j].y) + (yv[j].z * yv[j].z + yv[j].w * yv[j].w); }
    const float rs = 1.0f / sqrtf(wave_sum(s) * (1.f / DM) + NORM_EPS);
    float s2 = 0.f;
#pragma unroll
    for (int j = 0; j < 4; ++j) { const f32x4 gp = ((const f32x4*)gpost + lane)[64 * j]; hv[j] = ((const f32x4*)h + lane)[64 * j];
        hv[j].x += yv[j].x * rs * gp.x; hv[j].y += yv[j].y * rs * gp.y; hv[j].z += yv[j].z * rs * gp.z; hv[j].w += yv[j].w * rs * gp.w;
        ((f32x4*)h + lane)[64 * j] = hv[j];
        s2 += (hv[j].x * hv[j].x + hv[j].y * hv[j].y) + (hv[j].z * hv[j].z + hv[j].w * hv[j].w); }
    unsigned long long* o8 = (unsigned long long*)xn + lane;
    if (gnext) {
        const float rs2 = 1.0f / sqrtf(wave_sum(s2) * (1.f / DM) + NORM_EPS);
#pragma unroll
        for (int j = 0; j < 4; ++j) { const f32x4 gv = ((const f32x4*)gnext + lane)[64 * j];
            o8[64 * j] = (unsigned long long)pk2(hv[j].x * rs2 * gv.x, hv[j].y * rs2 * gv.y) | ((unsigned long long)pk2(hv[j].z * rs2 * gv.z, hv[j].w * rs2 * gv.w) << 32); }
    } else {
#pragma unroll
        for (int j = 0; j < 4; ++j) o8[64 * j] = (unsigned long long)pk2(hv[j].x, hv[j].y) | ((unsigned long long)pk2(hv[j].z, hv[j].w) << 32);
    }
}

__device__ __forceinline__ void attn_unit(LAS unsigned char* lds, int b, int qt, const half_t* Q, const half_t* KB, const half_t* VT, const half_t* QI, const v4u* KI, const float* WI, bf16* MIX, int tid, int lane, int w) {
    asm volatile("" : "+v"(tid)); lane = tid & 63;
    LAS v4u* kist = (LAS v4u*)lds;
    LAS unsigned* maskl = (LAS unsigned*)(lds + 16384);
    const int t0 = qt * 16; const size_t rowbase = (size_t)b * SEQ;
    const int hi = lane >> 5, j32 = lane & 31;
    const int tq = t0 + 2 * w + hi, tq1 = t0 + 2 * w + 1;
    const int ng = (tq1 >> 5) + 1;
    const int nch = ((t0 + 15) >> 7) + 1;
    unsigned mlo = 0u, mhi = 0u;
    {
        half8 aq[4];
        { const int qsel = (j32 >> 2) & 1, head = (j32 & 3) + 4 * (j32 >> 3);
          const half_t* qrow = QI + (rowbase + t0 + 2 * w + qsel) * 1024 + head * 64 + 8 * hi;
#pragma unroll
          for (int d0 = 0; d0 < 4; ++d0) aq[d0] = *(const half8*)(qrow + 16 * d0); }
        float wv[16];
        { const f32x4* wp = (const f32x4*)(WI + (rowbase + tq) * 16);
#pragma unroll
          for (int k = 0; k < 4; ++k) { const f32x4 x = wp[k]; wv[4 * k] = x.x; wv[4 * k + 1] = x.y; wv[4 * k + 2] = x.z; wv[4 * k + 3] = x.w; } }
        float sc[64];
#pragma unroll
        for (int g = 0; g < 64; ++g) sc[g] = -INFINITY;
#pragma unroll
        for (int kc = 0; kc < 16; ++kc) {
            if (kc < nch) {
                __syncthreads();
                { const GAS v4u* src = (const GAS v4u*)(KI + (size_t)(b * 16 + kc) * 1024); asm volatile("" : "+s"(src)); const v4u x0 = src[tid], x1 = src[tid + 512]; kist[tid] = x0; kist[tid + 512] = x1; }
                __syncthreads();
#pragma unroll
                for (int gg = 0; gg < 4; ++gg) {
                    const int g = kc * 4 + gg;
                    if (g < ng) {
                        f32x16 acc = {0.f, 0.f, 0.f, 0.f, 0.f, 0.f, 0.f, 0.f, 0.f, 0.f, 0.f, 0.f, 0.f, 0.f, 0.f, 0.f};
#pragma unroll
                        for (int d0 = 0; d0 < 4; ++d0) { const half8 bk = __builtin_bit_cast(half8, kist[(2 * d0 + hi) * 128 + gg * 32 + j32]);
                            acc = __builtin_amdgcn_mfma_f32_32x32x16_f16(aq[d0], bk, acc, 0, 0, 0); }
                        float s = 0.f;
#pragma unroll
                        for (int r = 0; r < 16; ++r) s += wv[r] * fmaxf(acc[r], 0.f);
                        sc[g] = s;
                    }
                }
            }
        }
        unsigned uk[64];
#pragma unroll
        for (int g = 0; g < 64; ++g) { const unsigned bts = __float_as_uint(sc[g]); const unsigned kk = (bts & 0x80000000u) ? ~bts : (bts | 0x80000000u);
            uk[g] = (32 * g + j32 <= tq) ? kk : 0u;
            if (DBG_SELECT_ALL == 2) uk[g] = (32 * g + j32 <= tq && ((32 * g + j32) == tq || (((unsigned)(32 * g + j32) * 2654435761u) >> 29) == 0u)) ? 5u : 0u; }
        unsigned thr = 0u; bool done = false;
        if (DBG_SELECT_ALL || tq + 1 <= 256) { thr = 1u; done = true; }
        for (int bit = 31; bit >= 0; --bit) {
            if (__all(done)) break;
            const unsigned cand = thr | (1u << bit);
            unsigned cnt = 0u;
#pragma unroll
            for (int blk = 0; blk < 8; ++blk) if (blk * 8 < ng) {
#pragma unroll
                for (int k = 0; k < 8; ++k) cnt += (uk[blk * 8 + k] >= cand) ? 1u : 0u; }
            cnt += (unsigned)__builtin_amdgcn_update_dpp(0, (int)cnt, 0xB1, 0xF, 0xF, true);
            cnt += (unsigned)__builtin_amdgcn_update_dpp(0, (int)cnt, 0x4E, 0xF, 0xF, true);
            cnt += (unsigned)__builtin_amdgcn_update_dpp(0, (int)cnt, 0x141, 0xF, 0xF, true);
            cnt += (unsigned)__builtin_amdgcn_update_dpp(0, (int)cnt, 0x140, 0xF, 0xF, true);
            const unsigned c0 = (unsigned)__builtin_amdgcn_readlane((int)cnt, 0) + (unsigned)__builtin_amdgcn_readlane((int)cnt, 16);
            const unsigned c1 = (unsigned)__builtin_amdgcn_readlane((int)cnt, 32) + (unsigned)__builtin_amdgcn_readlane((int)cnt, 48);
            const unsigned ch = hi ? c1 : c0;
            if (!done && ch >= 256u) thr = cand;
            if (ch == 256u) done = true;
        }
#define WL1(g) if ((g) < ng) { const unsigned long long bal = __ballot(uk[g] >= thr); \
            asm volatile("s_nop 4\n\tv_writelane_b32 %0, %2, " #g "\n\ts_nop 1\n\tv_writelane_b32 %1, %3, " #g "\n\ts_nop 1" : "+v"(mlo), "+v"(mhi) : "s"((unsigned)bal), "s"((unsigned)(bal >> 32))); }
#define WL8(a) WL1(a) WL1(a + 1) WL1(a + 2) WL1(a + 3) WL1(a + 4) WL1(a + 5) WL1(a + 6) WL1(a + 7)
        WL8(0) WL8(8) WL8(16) WL8(24) WL8(32) WL8(40) WL8(48) WL8(56)
#undef WL8
#undef WL1
    }
    maskl[(2 * w) * 64 + lane] = mlo; maskl[(2 * w + 1) * 64 + lane] = mhi;
    __syncthreads();
    {
        const int col = lane & 15, g4 = lane >> 4;
        const int kvh = w >> 2, qsub = w & 3;
        const int qloc = 4 * qsub + (col >> 2), tqa = t0 + qloc, hq = kvh * 4 + (col & 3);
        half8 bq0, bq1;
        { const half_t* qp = Q + (rowbase + tqa) * 512 + hq * 64 + 8 * g4; bq0 = *(const half8*)qp; bq1 = *(const half8*)(qp + 32); }
        const int ntile = ((t0 + 4 * qsub + 3) >> 5) + 1;
        float mrun = -INFINITY, lrun = 0.f;
        f32x4 o[4];
#pragma unroll
        for (int d = 0; d < 4; ++d) o[d] = (f32x4){0.f, 0.f, 0.f, 0.f};
        const half_t* kp = KB + (rowbase + (lane & 15)) * 128 + kvh * 64 + 8 * g4;
        const half_t* vp = VT + ((size_t)((b * 2 + kvh) * 64 + (lane & 15)) * 2048) + 4 * g4;
        const LAS unsigned* mq = maskl + qloc * 64;
        for (int kt = 0; kt < ntile; ++kt) {
            const int k0 = kt * 32;
            const half8 ka00 = *(const half8*)(kp + (size_t)k0 * 128), ka01 = *(const half8*)(kp + (size_t)k0 * 128 + 32);
            const half8 ka10 = *(const half8*)(kp + (size_t)(k0 + 16) * 128), ka11 = *(const half8*)(kp + (size_t)(k0 + 16) * 128 + 32);
            half4 va[4], vb[4];
#pragma unroll
            for (int d = 0; d < 4; ++d) { va[d] = *(const half4*)(vp + (size_t)d * 16 * 2048 + k0); vb[d] = *(const half4*)(vp + (size_t)d * 16 * 2048 + k0 + 16); }
            const f32x4 z4 = {0.f, 0.f, 0.f, 0.f};
            f32x4 s0 = __builtin_amdgcn_mfma_f32_16x16x32_f16(ka00, bq0, z4, 0, 0, 0); s0 = __builtin_amdgcn_mfma_f32_16x16x32_f16(ka01, bq1, s0, 0, 0, 0);
            f32x4 s1 = __builtin_amdgcn_mfma_f32_16x16x32_f16(ka10, bq0, z4, 0, 0, 0); s1 = __builtin_amdgcn_mfma_f32_16x16x32_f16(ka11, bq1, s1, 0, 0, 0);
            const unsigned mw = mq[kt];
            const unsigned b0 = mw >> (4 * g4), b1 = mw >> (16 + 4 * g4);
            float x[8];
#pragma unroll
            for (int i = 0; i < 4; ++i) { x[i] = ((b0 >> i) & 1u) ? s0[i] : -INFINITY; x[4 + i] = ((b1 >> i) & 1u) ? s1[i] : -INFINITY; }
            float mt = fmaxf(fmaxf(fmaxf(x[0], x[1]), fmaxf(x[2], x[3])), fmaxf(fmaxf(x[4], x[5]), fmaxf(x[6], x[7])));
            mt = fmaxf(mt, __shfl_xor(mt, 16)); mt = fmaxf(mt, __shfl_xor(mt, 32));
            const float mnew = fmaxf(mrun, mt);
            const float msafe = (mnew == -INFINITY) ? 0.f : mnew;
            const float alpha = __builtin_amdgcn_exp2f(mrun - msafe);
            float p[8], ps = 0.f;
#pragma unroll
            for (int e = 0; e < 8; ++e) { p[e] = __builtin_amdgcn_exp2f(x[e] - msafe); ps += p[e]; }
            lrun = lrun * alpha + ps; mrun = mnew;
            half8 pb;
#pragma unroll
            for (int e = 0; e < 8; ++e) pb[e] = (half_t)p[e];
#pragma unroll
            for (int d = 0; d < 4; ++d) { o[d] = o[d] * alpha;
                const half8 v8 = {va[d][0], va[d][1], va[d][2], va[d][3], vb[d][0], vb[d][1], vb[d][2], vb[d][3]};
                o[d] = __builtin_amdgcn_mfma_f32_16x16x32_f16(v8, pb, o[d], 0, 0, 0); }
        }
        float lt = lrun + __shfl_xor(lrun, 16); lt += __shfl_xor(lt, 32);
        const float inv = 1.0f / lt;
        bf16* op = MIX + (rowbase + tqa) * 1024 + hq * 64 + 4 * g4;
#pragma unroll
        for (int d = 0; d < 4; ++d) { u32x2 wv2; wv2.x = pk2(o[d][0] * inv, o[d][1] * inv); wv2.y = pk2(o[d][2] * inv, o[d][3] * inv); *(u32x2*)(op + 16 * d) = wv2; }
    }
    __syncthreads();
}

__device__ __forceinline__ void conv_unit(LAS unsigned char* lds, int tok0, const half_t* UC, const float* dw, const float* cb, const float* lng, const float* lnb, const bf16* WT, bf16* MIX, int tid, int lane, int w) {
    LAS float* yl = (LAS float*)lds;
    LAS float* zl = (LAS float*)(lds + 62 * 256 * 4);
    LAS bf16* act = (LAS bf16*)(lds + 62 * 256 * 4 + 32 * 256 * 4);
    const int ts = tok0 & (SEQ - 1); const size_t rowb = (size_t)(tok0 - ts);
    for (int task = tid; task < 62 * 32; task += NWAVES * 64) {
        const int r = task >> 5, c8 = (task & 31) * 8, tp = ts - 30 + r;
        f32x4 y0 = {0.f, 0.f, 0.f, 0.f}, y1 = y0;
        if (tp >= 0) { const half_t* up = UC + (rowb + tp) * 512 + c8; const half8 a = *(const half8*)up, g = *(const half8*)(up + 256);
            float yy[8];
#pragma unroll
            for (int e = 0; e < 8; ++e) yy[e] = (float)a[e] * __builtin_amdgcn_rcpf(1.f + __builtin_amdgcn_exp2f(-1.4426950408889634f * (float)g[e]));
            y0 = (f32x4){yy[0], yy[1], yy[2], yy[3]}; y1 = (f32x4){yy[4], yy[5], yy[6], yy[7]}; }
        *(LAS f32x4*)(yl + r * 256 + c8) = y0; *(LAS f32x4*)(yl + r * 256 + c8 + 4) = y1;
    }
    __syncthreads();
    { const int c = tid & 255, th = tid >> 8;
      float dwr[31];
#pragma unroll
      for (int j = 0; j < 31; ++j) dwr[j] = dw[j * 256 + c];
      const float bias = cb[c];
      float yw[31];
#pragma unroll
      for (int it = 0; it < 46; ++it) {
          yw[it % 31] = yl[(16 * th + it) * 256 + c];
          if (it >= 30) { float z = bias;
#pragma unroll
              for (int j = 0; j < 31; ++j) z += dwr[j] * yw[(it - 30 + j) % 31];
              zl[(16 * th + it - 30) * 256 + c] = z; }
      } }
    __syncthreads();
#pragma unroll
    for (int q = 0; q < 4; ++q) { const int tok = 4 * w + q;
        const f32x4 z = *(const LAS f32x4*)(zl + tok * 256 + 4 * lane);
        const float mean = wave_sum((z.x + z.y) + (z.z + z.w)) * (1.f / 256);
        const f32x4 d = z - mean;
        const float var = wave_sum((d.x * d.x + d.y * d.y) + (d.z * d.z + d.w * d.w)) * (1.f / 256);
        const float rstd = 1.0f / sqrtf(var + LN_EPS);
        const f32x4 gv = *(const f32x4*)(lng + 4 * lane), bv = *(const f32x4*)(lnb + 4 * lane);
        float yy[4];
#pragma unroll
        for (int e = 0; e < 4; ++e) { const float t = d[e] * rstd * gv[e] + bv[e]; yy[e] = t * __builtin_amdgcn_rcpf(1.f + __builtin_amdgcn_exp2f(-1.4426950408889634f * t)); }
        u32x2 pw; pw.x = pk2(yy[0], yy[1]); pw.y = pk2(yy[2], yy[3]);
        *(LAS u32x2*)(act + tok * 264 + 4 * lane) = pw;
    }
    __syncthreads();
    { const int r16 = lane & 15, g4 = lane >> 4;
#pragma unroll
      for (int q = 0; q < 2; ++q) { const int nt = 2 * w + q;
          f32x4 a0 = {0.f, 0.f, 0.f, 0.f}, a1 = a0;
#pragma unroll
          for (int kb = 0; kb < 8; ++kb) {
              const bf16x8 wf = *(const bf16x8*)(WT + (size_t)(nt * 16 + r16) * 256 + kb * 32 + 8 * g4);
              const bf16x8 x0 = *(const LAS bf16x8*)(act + r16 * 264 + kb * 32 + 8 * g4), x1 = *(const LAS bf16x8*)(act + (16 + r16) * 264 + kb * 32 + 8 * g4);
              a0 = __builtin_amdgcn_mfma_f32_16x16x32_bf16(wf, x0, a0, 0, 0, 0); a1 = __builtin_amdgcn_mfma_f32_16x16x32_bf16(wf, x1, a1, 0, 0, 0);
          }
          bf16* o0 = MIX + (size_t)(tok0 + r16) * 1024 + 512 + nt * 16 + 4 * g4; bf16* o1 = o0 + (size_t)16 * 1024;
          u32x2 p0, p1; p0.x = pk2(a0[0], a0[1]); p0.y = pk2(a0[2], a0[3]); p1.x = pk2(a1[0], a1[1]); p1.y = pk2(a1[2], a1[3]);
          *(u32x2*)o0 = p0; *(u32x2*)o1 = p1;
      } }
    __syncthreads();
}

__device__ __forceinline__ void pool_unit(LAS unsigned char* lds, int tok0, const half_t* UP, const bf16* WT, const float* pscale, bf16* MIX, int tid, int lane, int w) {
    LAS float* ul = (LAS float*)lds;
    LAS bf16* act = (LAS bf16*)(lds + 79 * 256 * 4);
    const int ts = tok0 & (SEQ - 1); const size_t rowb = (size_t)(tok0 - ts);
    for (int task = tid; task < 79 * 32; task += NWAVES * 64) {
        const int r = task >> 5, c8 = (task & 31) * 8, tp = ts - 15 + r;
        f32x4 y0 = {0.f, 0.f, 0.f, 0.f}, y1 = y0;
        if (tp >= 0) { const half8 a = *(const half8*)(UP + (rowb + tp) * 256 + c8);
            y0 = (f32x4){(float)a[0], (float)a[1], (float)a[2], (float)a[3]}; y1 = (f32x4){(float)a[4], (float)a[5], (float)a[6], (float)a[7]}; }
        *(LAS f32x4*)(ul + r * 256 + c8) = y0; *(LAS f32x4*)(ul + r * 256 + c8 + 4) = y1;
    }
    __syncthreads();
    { const int c = tid & 255, th = tid >> 8, gi = c >> 6, wlen = 2 << gi;
      for (int q = 0; q < 32; ++q) { const int tt = 32 * th + q, row = tt + 15;
          float s = 0.f;
          for (int i = 0; i < wlen; ++i) s += ul[(row - i) * 256 + c];
          const int cnt = min(ts + tt + 1, wlen);
          const float y = s / (float)cnt - ul[row * 256 + c];
          act[tt * 264 + c] = (bf16)f2bf(y); } }
    __syncthreads();
    { const int r16 = lane & 15, g4 = lane >> 4, gi = w >> 1;
#pragma unroll
      for (int q = 0; q < 2; ++q) { const int dt = 2 * (w & 1) + q;
          f32x4 a[4];
#pragma unroll
          for (int t4 = 0; t4 < 4; ++t4) a[t4] = (f32x4){0.f, 0.f, 0.f, 0.f};
#pragma unroll
          for (int kb = 0; kb < 2; ++kb) {
              const bf16x8 wf = *(const bf16x8*)(WT + (size_t)gi * 4096 + (dt * 16 + r16) * 64 + kb * 32 + 8 * g4);
#pragma unroll
              for (int t4 = 0; t4 < 4; ++t4) { const bf16x8 xf = *(const LAS bf16x8*)(act + (t4 * 16 + r16) * 264 + gi * 64 + kb * 32 + 8 * g4);
                  a[t4] = __builtin_amdgcn_mfma_f32_16x16x32_bf16(wf, xf, a[t4], 0, 0, 0); }
          }
          const int ch = gi * 64 + dt * 16 + 4 * g4;
          const f32x4 sc = *(const f32x4*)(pscale + ch);
#pragma unroll
          for (int t4 = 0; t4 < 4; ++t4) { u32x2 pw; pw.x = pk2(a[t4][0] * sc.x, a[t4][1] * sc.y); pw.y = pk2(a[t4][2] * sc.z, a[t4][3] * sc.w);
              *(u32x2*)(MIX + (size_t)(tok0 + t4 * 16 + r16) * 1024 + 768 + ch) = pw; }
      } }
    __syncthreads();
}

#ifndef EN_T
#define EN_T 1
#endif
#ifndef EN_G
#define EN_G 1
#endif
#ifndef EN_GMASK
#define EN_GMASK 31
#endif
#ifndef DBG_SELECT_ALL
#define DBG_SELECT_ALL 0
#endif
#ifndef EN_ATTN
#define EN_ATTN 1
#endif
#ifndef EN_CONV
#define EN_CONV 1
#endif
#ifndef EN_POOL
#define EN_POOL 1
#endif
struct Args { const float* in[20]; float* out; unsigned char* ws; int ph_lo, ph_hi, li, pad; };
__global__ void __launch_bounds__(NWAVES * 64, 2) fwd(Args args) {
    extern __shared__ __attribute__((aligned(16))) unsigned char lds_raw[];
    LAS unsigned char* lds = (LAS unsigned char*)lds_raw;
    volatile LAS unsigned* MISC = (volatile LAS unsigned*)(lds + MISC_OFF);
    const int tid0 = threadIdx.x;
    const int G = gridDim.x; const int bx = blockIdx.x; const int vcu = (G % 8 == 0) ? (bx % 8) * (G / 8) + bx / 8 : bx;
    unsigned char* ws = args.ws;
    gu32* ctl = (gu32*)(ws + WS_CTL);
    for (int u = tid0; u < (LDS_BYTES - LDSCTL_OFF) / 4; u += NWAVES * 64) ((LAS unsigned*)(lds + LDSCTL_OFF))[u] = 0u;
    __syncthreads();
    XcdBarrier bar = xcd_barrier_post((unsigned*)(ctl + CW_BAR) + args.li * XCD_BAR_WORDS, MISC + 8);
    const int lo = args.ph_lo, hi = args.ph_hi;
#define IN(k) (lo <= (k) && (k) < hi)
#define PHASE_IDS() int tid = threadIdx.x; asm volatile("" : "+v"(tid)); const int lane = tid & 63, wave = __builtin_amdgcn_readfirstlane(tid >> 6); const int gw = vcu * NWAVES + wave; (void)gw; (void)lane
#define SEAM(k) do { if (IN(k) && IN((k) + 1)) xcd_barrier(bar); } while (0)

    const float* x = args.in[0];
    const int NGW = G * NWAVES;

    if (EN_T && IN(0)) {
        int tid = threadIdx.x; asm volatile("" : "+v"(tid));
        float* ROPE0 = (float*)(ws + WS_ROPE);
        const int* pos = (const int*)args.in[2];
        for (int i = vcu * (NWAVES * 64) + tid; i < M * 8; i += G * NWAVES * 64) { const int m = i >> 3, e = i & 7;
            constexpr float invf[8] = {1.0f, 0.1939227432012558f, 0.03760603070259094f, 0.007292664609849453f, 0.0014142135623842478f, 0.00027424818836152554f, 5.318296098266728e-05f, 1.0313386155758053e-05f};
            float iv = invf[0];
#pragma unroll
            for (int k = 1; k < 8; ++k) iv = (e == k) ? invf[k] : iv;
            const float ang = (float)pos[m] * iv; float c, sn; sincos_acc(ang, c, sn);
            ROPE0[(size_t)m * 16 + e] = c; ROPE0[(size_t)m * 16 + 8 + e] = sn; }
    }
    for (int li = 0; li < NLAYER; ++li) {
        const int pb = li * PH_PER_LAYER;
        GAS unsigned char* wsl1 = (GAS unsigned char*)ws; asm volatile("" : "+s"(wsl1)); unsigned char* wsl = (unsigned char*)wsl1;
        GAS float* hres1 = (GAS float*)args.out; asm volatile("" : "+s"(hres1)); float* hres = (float*)hres1;
        int bxl = bx; asm volatile("" : "+s"(bxl));
        bf16* W_IN = (bf16*)(wsl + WS_WIN); bf16* W_OUT = (bf16*)(wsl + WS_WOUT); bf16* W_UP = (bf16*)(wsl + WS_WUP); bf16* W_DN = (bf16*)(wsl + WS_WDN);
        bf16* W_GATE = (bf16*)(wsl + WS_WGATE); bf16* W_PLE = (bf16*)(wsl + WS_WPLE); bf16* W_CPW = (bf16*)(wsl + WS_WCPW); bf16* W_POOL = (bf16*)(wsl + WS_WPOOL);
        float* ROPE = (float*)(wsl + WS_ROPE); bf16* PB = (bf16*)(wsl + WS_P); bf16* XN = (bf16*)(wsl + WS_XN); bf16* YB = (bf16*)(wsl + WS_Y); bf16* HD = (bf16*)(wsl + WS_HD);
        half_t* Qb = (half_t*)(wsl + WS_Q); half_t* QIb = (half_t*)(wsl + WS_QI); half_t* UCb = (half_t*)(wsl + WS_UC); half_t* UPb = (half_t*)(wsl + WS_UP);
        half_t* KBb = (half_t*)(wsl + WS_KB); half_t* VTb = (half_t*)(wsl + WS_VT); v4u* KIb = (v4u*)(wsl + WS_KI); float* WIb = (float*)(wsl + WS_WI); bf16* MIX = (bf16*)(wsl + WS_MIX);
        if (EN_T && IN(pb + 0)) {
            PHASE_IDS();
            LAS float* scr = (LAS float*)(lds + wave * 16384);
            const float* w_in = args.in[4] + (size_t)li * DM * 2640; const float* w_out = args.in[12] + (size_t)li * DM * DM; const float* w_up = args.in[15] + (size_t)li * DM * FF;
            const float* w_dn = args.in[16] + (size_t)li * FF * DM; const float* w_gate = args.in[19] + (size_t)li * DM * DM; const float* w_ple = args.in[18] + (size_t)li * PLE_DIM * DM;
            const float* w_cpw = args.in[9] + (size_t)li * 256 * 256; const float* w_pool = args.in[10] + (size_t)li * 4 * 64 * 64;
            constexpr int I_IN = 16 * 88, I_OUT = 16 * 32, I_UP = 16 * 128, I_DN = 64 * 32, I_GATE = 16 * 32, I_PLE = 4 * 32, I_CPW = 4 * 8, I_POOL = 8;
            constexpr int NITEMS = I_IN + I_OUT + I_UP + I_DN + I_GATE + I_PLE + I_CPW + I_POOL;
            for (int it = gw; it < NITEMS; it += NGW) {
                int r = it;
                if (r < I_IN) { const int kb = r / 88, db = r % 88; int scol, nv;
                    if (db < 56) { scol = 32 * db; nv = 32; } else if (db < 80) { scol = 1872 + 32 * (db - 56); nv = 32; } else if (db < 82) { scol = 1792 + 32 * (db - 80); nv = 32; }
                    else if (db == 82) { scol = 1856; nv = 16; } else { scol = 0; nv = 0; }
                    tr_item(w_in, DM, 2640, scol, nv, W_IN, 32 * db, 64 * kb, scr, lane); continue; } r -= I_IN;
                if (r < I_OUT) { tr_item(w_out, DM, DM, 32 * (r % 32), 32, W_OUT, 32 * (r % 32), 64 * (r / 32), scr, lane); continue; } r -= I_OUT;
                if (r < I_UP) { tr_item(w_up, DM, FF, 32 * (r % 128), 32, W_UP, 32 * (r % 128), 64 * (r / 128), scr, lane); continue; } r -= I_UP;
                if (r < I_DN) { tr_item(w_dn, FF, DM, 32 * (r % 32), 32, W_DN, 32 * (r % 32), 64 * (r / 32), scr, lane); continue; } r -= I_DN;
                if (r < I_GATE) { tr_item(w_gate, DM, DM, 32 * (r % 32), 32, W_GATE, 32 * (r % 32), 64 * (r / 32), scr, lane); continue; } r -= I_GATE;
                if (r < I_PLE) { tr_item(w_ple, PLE_DIM, DM, 32 * (r % 32), 32, W_PLE, 32 * (r % 32), 64 * (r / 32), scr, lane); continue; } r -= I_PLE;
                if (r < I_CPW) { tr_item(w_cpw, 256, 256, 32 * (r % 8), 32, W_CPW, 32 * (r % 8), 64 * (r / 8), scr, lane); continue; } r -= I_CPW;
                { const int gi = r >> 1; tr_item(w_pool + gi * 4096, 64, 64, 32 * (r & 1), 32, W_POOL + gi * 4096, 32 * (r & 1), 0, scr, lane); }
            }
            const float* pin = args.in[1] + (size_t)li * M * PLE_DIM;
            for (int m = gw; m < M; m += NGW) { const f32x4 v = ((const f32x4*)(pin + (size_t)m * PLE_DIM))[lane];
                ((unsigned long long*)(PB + (size_t)m * PLE_DIM))[lane] = (unsigned long long)pk2(v.x, v.y) | ((unsigned long long)pk2(v.z, v.w) << 32); }
            const float* g0 = args.in[3] + (size_t)li * DM;
            for (int m = gw; m < M; m += NGW) t0_row((li == 0 ? x : hres) + (size_t)m * DM, li == 0 ? hres + (size_t)m * DM : nullptr, g0, XN + (size_t)m * DM, lane);
        }
        SEAM(pb + 0);
        if (EN_G && (EN_GMASK & 1) && IN(pb + 1)) {
            pg8::Gemm g{XN, W_IN, M, NIN, DM}; pg8::StaticOrder S; S.init(M, NIN, G, bxl);
            pg8::EpiIn E{Qb, KBb, VTb, QIb, (pg8::u32x4*)KIb, WIb, UCb, UPb, ROPE, QSCALE};
            pg8::gemm_phase<pg8::EpiIn, pg8::StaticOrder, true, true>(lds, g, S, E);
        }
        SEAM(pb + 1);
        if (IN(pb + 2)) {
            PHASE_IDS();
            const int b = vcu >> 5, s = vcu & 31;
#pragma unroll 1
            for (int i = 0; i < (EN_ATTN ? 4 : 0); ++i) { const int qt = (i == 0) ? s : (i == 1) ? 63 - s : (i == 2) ? 64 + s : 127 - s;
                attn_unit(lds, b, qt, Qb, KBb, VTb, QIb, KIb, WIb, MIX, tid, lane, wave); }
            const float* cdw = args.in[5] + (size_t)li * 31 * 256; const float* cbi = args.in[6] + (size_t)li * 256; const float* clg = args.in[7] + (size_t)li * 256; const float* clb = args.in[8] + (size_t)li * 256;
#pragma unroll 1
            for (int i = 0; i < (EN_CONV ? 2 : 0); ++i) conv_unit(lds, vcu * 64 + 32 * i, UCb, cdw, cbi, clg, clb, W_CPW, MIX, tid, lane, wave);
            if (EN_POOL) pool_unit(lds, vcu * 64, UPb, W_POOL, args.in[11] + (size_t)li * 256, MIX, tid, lane, wave);
            if (!EN_ATTN || !EN_CONV || !EN_POOL) {
                for (int m = vcu * 64 + wave * 8; m < vcu * 64 + wave * 8 + 8; ++m) {
                    unsigned long long* rowp = (unsigned long long*)(MIX + (size_t)m * 1024);
                    for (int j = 0; j < 4; ++j) { const int piece = lane + 64 * j; const int colx = piece * 4;
                        const bool z = (colx < 512) ? !EN_ATTN : (colx < 768) ? !EN_CONV : !EN_POOL;
                        if (z) rowp[piece] = 0ull; } }
            }
        }
        SEAM(pb + 2);
        if (EN_G && (EN_GMASK & 2) && IN(pb + 3)) {
            pg8::Gemm g{MIX, W_OUT, M, DM, DM}; pg8::StaticOrder S; S.init(M, DM, G, bxl);
            pg8::EpiBf16<0> E{YB, DM};
            pg8::gemm_phase<pg8::EpiBf16<0>, pg8::StaticOrder, false, true>(lds, g, S, E);
        }
        SEAM(pb + 3);
        if (EN_T && IN(pb + 4)) {
            PHASE_IDS();
            const float* gp = args.in[13] + (size_t)li * DM; const float* gn = args.in[14] + (size_t)li * DM;
            for (int m = gw; m < M; m += NGW) tres_row(YB + (size_t)m * DM, gp, hres + (size_t)m * DM, gn, XN + (size_t)m * DM, lane);
        }
        SEAM(pb + 4);
        if (EN_G && (EN_GMASK & 4) && IN(pb + 5)) {
            pg8::Gemm g{XN, W_UP, M, FF, DM}; pg8::StaticOrder S; S.init(M, FF, G, bxl);
            pg8::EpiBf16<1> E{HD, FF};
            pg8::gemm_phase<pg8::EpiBf16<1>, pg8::StaticOrder, true, true>(lds, g, S, E);
        }
        SEAM(pb + 5);
        if (EN_G && (EN_GMASK & 8) && IN(pb + 6)) {
            pg8::Gemm g{HD, W_DN, M, DM, FF}; pg8::StaticOrder S; S.init(M, DM, G, bxl);
            pg8::EpiBf16<0> E{YB, DM};
            pg8::gemm_phase<pg8::EpiBf16<0>, pg8::StaticOrder, false, true>(lds, g, S, E);
        }
        SEAM(pb + 6);
        if (EN_T && IN(pb + 7)) {
            PHASE_IDS();
            const float* gp = args.in[17] + (size_t)li * DM;
            for (int m = gw; m < M; m += NGW) tres_row(YB + (size_t)m * DM, gp, hres + (size_t)m * DM, nullptr, XN + (size_t)m * DM, lane);
        }
        SEAM(pb + 7);
        if (EN_G && (EN_GMASK & 16) && IN(pb + 8)) {
            { pg8::Gemm g{PB, W_PLE, M, DM, PLE_DIM}; pg8::StaticOrder S; S.init(M, DM, G, bxl);
              pg8::EpiBf16<0> E{YB, DM};
              pg8::gemm_phase<pg8::EpiBf16<0>, pg8::StaticOrder, false, true>(lds, g, S, E); }
            VM_WAIT(); __syncthreads();
            { pg8::Gemm g{XN, W_GATE, M, DM, DM}; pg8::StaticOrder S; S.init(M, DM, G, bxl);
              pg8::EpiGate E{hres, YB};
              pg8::gemm_phase<pg8::EpiGate, pg8::StaticOrder, false, true>(lds, g, S, E); }
        }
        SEAM(pb + 8);
    }
#undef IN
#undef SEAM
}

extern "C" void kernel_launch(void* const* d_in, const int* in_sizes, int n_in, void* d_out, int out_size, void* d_ws, size_t ws_size, hipStream_t stream) {
    static int grid = 0;
    if (grid == 0) {
        if (n_in != 20 || in_sizes[0] != M * DM || out_size != M * DM || ws_size < WS_END) { fprintf(stderr, "kernel_launch: unexpected shapes (n_in %d, in0 %d, out %d, ws %zu); nothing launched\n", n_in, n_in > 0 ? in_sizes[0] : -1, out_size, ws_size); grid = -1; return; }
        int dev = 0, cus = 0, per_cu = 0;
        if (hipGetDevice(&dev) != hipSuccess || hipDeviceGetAttribute(&cus, hipDeviceAttributeMultiprocessorCount, dev) != hipSuccess) { grid = -1; return; }
        if (hipFuncSetAttribute((const void*)fwd, hipFuncAttributeMaxDynamicSharedMemorySize, LDS_BYTES) != hipSuccess) { fprintf(stderr, "kernel_launch: hipFuncSetAttribute failed\n"); grid = -1; return; }
        if (hipOccupancyMaxActiveBlocksPerMultiprocessor(&per_cu, (const void*)fwd, NWAVES * 64, LDS_BYTES) != hipSuccess || per_cu < 1) fprintf(stderr, "kernel_launch: occupancy query reports %d workgroups per CU\n", per_cu);
        (void)hipGetLastError();
        grid = 256;
        if (cus < 256) { fprintf(stderr, "kernel_launch: %d CUs < 256; nothing launched\n", cus); grid = -1; return; }
    }
    if (grid < 0) return;
    if (hipMemsetAsync((char*)d_ws + WS_CTL, 0, CTL_ZERO_BYTES, stream) != hipSuccess) return;
    Args a{};
    for (int i = 0; i < 20; ++i) a.in[i] = (const float*)d_in[i];
    a.out = (float*)d_out; a.ws = (unsigned char*)d_ws; a.pad = 0;
    for (int li = 0; li < N_LAUNCHES; ++li) {
        if (N_LAUNCHES == 1) { a.ph_lo = 0; a.ph_hi = NPHASE; } else { a.ph_lo = li * (NPHASE / N_LAUNCHES); a.ph_hi = (li + 1) * (NPHASE / N_LAUNCHES); }
        a.li = li;
        hipLaunchKernelGGL(fwd, dim3(grid), dim3(NWAVES * 64), LDS_BYTES, stream, a);
        if (hipPeekAtLastError() != hipSuccess) { fprintf(stderr, "kernel_launch: launch %d failed\n", li); break; }
    }
}
```

```cpp
#include <hip/hip_runtime.h>
#include <cstdio>
#include <cstdint>
#ifndef DBG_SELECT_ALL
#define DBG_SELECT_ALL 0
#endif
#ifndef REP_ATTN
#define REP_ATTN 1
#endif
#ifndef REP_CONV
#define REP_CONV 1
#endif
#ifndef REP_POOL
#define REP_POOL 1
#endif
#ifndef REP_T0
#define REP_T0 1
#endif
#ifndef REP_G1
#define REP_G1 1
#endif
#ifndef REP_G2
#define REP_G2 1
#endif
#ifndef REP_G3
#define REP_G3 1
#endif
#ifndef REP_G4
#define REP_G4 1
#endif
namespace pg8 {
#define PG8_LAS __attribute__((address_space(3)))
typedef unsigned short bf16_t;
typedef short bf16x8 __attribute__((ext_vector_type(8)));
typedef float f32x4 __attribute__((ext_vector_type(4)));
typedef unsigned u32x4 __attribute__((ext_vector_type(4)));
constexpr int BM = 256, BK = 64, HALF = 128, HTB = HALF * BK * 2  , STAGE_BYTES = 8 * HTB, NXCD = 8, WGM = 8;

__host__ __device__ __forceinline__ int lds_byte(int r, int c) { const int st = (r >> 4) * 2 + (c >> 5), rr = r & 15, cc = c & 31, ob = rr * 64 + cc * 2; return st * 1024 + (ob ^ (((ob >> 9) & 1) << 5)); }
__host__ __device__ __forceinline__ void stage_rc(int b, int& R, int& C) { const int st = b / 1024, sb = b % 1024, swz = sb ^ (((sb >> 9) & 1) << 5); R = (st >> 1) * 16 + swz / 64; C = (st & 1) * 32 + (swz % 64) / 2; }
__host__ __device__ __forceinline__ int perm32(int rho) { const int n = rho >> 4, i = rho & 15; return 8 * (i >> 2) + 4 * n + (i & 3); }

struct Unit { int pm, pn; };
struct Gemm { const bf16_t* A; const bf16_t* Bt; int M, N, K; };

struct StaticOrder {
    int nM, nN, nwg, G, c;
    __host__ __device__ void init(int M, int N, int G_, int c_) { nM = M / BM; nN = N / BM; nwg = nM * nN; G = G_; c = c_; }
    __host__ __device__ bool next(int i, Unit& u) const {
        const long L = (long)i * G + c; if (L >= nwg) return false;
        int wgid = (int)L; { const int q = nwg / NXCD, r = nwg % NXCD, xcd = wgid % NXCD, off = wgid / NXCD; wgid = (xcd < r ? xcd * (q + 1) : r * (q + 1) + (xcd - r) * q) + off; }
        const int nig = WGM * nN, gid = wgid / nig, fm = gid * WGM, gsz = (nM - fm) < WGM ? (nM - fm) : WGM;
        u.pm = fm + ((wgid % nig) % gsz); u.pn = (wgid % nig) / gsz; return true;
    }
    __device__ __forceinline__ void a_ready(const Unit&) const {}
    __device__ __forceinline__ void done(const Unit&) const {}
};

__device__ __forceinline__ unsigned cvt_pk_bf16(float lo, float hi) { unsigned r; asm volatile("v_cvt_pk_bf16_f32 %0, %1, %2" : "=v"(r) : "v"(lo), "v"(hi)); return r; }
typedef float f32x2 __attribute__((ext_vector_type(2)));
typedef _Float16 half_t;
typedef _Float16 half8 __attribute__((ext_vector_type(8)));
typedef _Float16 half4 __attribute__((ext_vector_type(4)));
typedef float f32x8 __attribute__((ext_vector_type(8)));
typedef float f32x16 __attribute__((ext_vector_type(16)));

template <int ACT> struct EpiBf16 {
    static constexpr bool PERM = true, AFTER_DRAIN = false;
    bf16_t* O; int ldc;
    __device__ __forceinline__ void operator()(const f32x4 (&acc)[2][2][4][2], const Unit& u, int wr, int wc, int fr, int fq) const {
        asm volatile("" : "+v"(fr));
        const int row0 = u.pm * BM + wr * 64 + fr, col0 = u.pn * BM + wc * 32 + 8 * fq;
#pragma unroll
        for (int ai = 0; ai < 2; ++ai)
#pragma unroll
            for (int m = 0; m < 4; ++m) { bf16_t* rowp = O + (size_t)(row0 + ai * HALF + m * 16) * ldc + col0;
#pragma unroll
                for (int bj = 0; bj < 2; ++bj) { f32x4 v0 = acc[ai][bj][m][0], v1 = acc[ai][bj][m][1];
                    if (ACT == 1) {
#pragma unroll
                        for (int e = 0; e < 4; ++e) { const float a = fmaxf(v0[e], 0.f), b = fmaxf(v1[e], 0.f); v0[e] = a * a; v1[e] = b * b; } }
                    u32x4 w; w.x = cvt_pk_bf16(v0[0], v0[1]); w.y = cvt_pk_bf16(v0[2], v0[3]); w.z = cvt_pk_bf16(v1[0], v1[1]); w.w = cvt_pk_bf16(v1[2], v1[3]);
                    *(u32x4*)(rowp + bj * HALF) = w; } }
    }
};

struct EpiGate {
    static constexpr bool PERM = true, AFTER_DRAIN = false;
    float* H; const bf16_t* PLE;
    __device__ __forceinline__ void operator()(const f32x4 (&acc)[2][2][4][2], const Unit& u, int wr, int wc, int fr, int fq) const {
        asm volatile("" : "+v"(fr));
        const int row0 = u.pm * BM + wr * 64 + fr, col0 = u.pn * BM + wc * 32 + 8 * fq;
#pragma unroll
        for (int ai = 0; ai < 2; ++ai)
#pragma unroll
            for (int m = 0; m < 4; ++m) { const size_t ro = (size_t)(row0 + ai * HALF + m * 16) * 1024 + col0;
#pragma unroll
                for (int bj = 0; bj < 2; ++bj) { const size_t off = ro + bj * HALF;
                    const u32x4 pw = *(const u32x4*)(PLE + off);
                    f32x4 h0 = *(const f32x4*)(H + off), h1 = *(const f32x4*)(H + off + 4);
                    const f32x4 a0 = acc[ai][bj][m][0], a1 = acc[ai][bj][m][1];
                    float pl[8];
#pragma unroll
                    for (int e = 0; e < 4; ++e) { pl[2 * e] = __uint_as_float(pw[e] << 16); pl[2 * e + 1] = __uint_as_float(pw[e] & 0xffff0000u); }
#pragma unroll
                    for (int e = 0; e < 4; ++e) {
                        const float g0 = __builtin_amdgcn_rcpf(1.f + __builtin_amdgcn_exp2f(-1.4426950408889634f * a0[e]));
                        const float g1 = __builtin_amdgcn_rcpf(1.f + __builtin_amdgcn_exp2f(-1.4426950408889634f * a1[e]));
                        h0[e] += g0 * pl[e]; h1[e] += g1 * pl[4 + e]; }
                    *(f32x4*)(H + off) = h0; *(f32x4*)(H + off + 4) = h1; }
                asm volatile("" ::: "memory"); }
    }
};

struct EpiIn {
    static constexpr bool PERM = true, AFTER_DRAIN = false;
    half_t* Q; half_t* KB; half_t* VT; half_t* QI; u32x4* KI; float* WI; half_t* UC; half_t* UP; const float* ROPE; float qscale;
    __device__ __forceinline__ void operator()(const f32x4 (&acc)[2][2][4][2], const Unit& u, int wr, int wc, int fr, int fq) const {
        asm volatile("" : "+v"(fr));
        const int pn = u.pn;
        const bool ropew = ((pn <= 6) || (pn == 10)) && ((wc & 1) == 0);
#pragma unroll
        for (int ai = 0; ai < 2; ++ai)
#pragma unroll
            for (int m = 0; m < 4; ++m) {
                const int row = u.pm * BM + ai * HALF + wr * 64 + m * 16 + fr;
                const int bb = row >> 11, tt = row & 2047;
                f32x4 cs0 = {1.f, 1.f, 1.f, 1.f}, cs1 = cs0, sn0 = {0.f, 0.f, 0.f, 0.f}, sn1 = sn0;
                if (ropew) { const f32x4* rp = (const f32x4*)(ROPE + (size_t)row * 16); cs0 = rp[0]; cs1 = rp[1]; sn0 = rp[2]; sn1 = rp[3]; }
#pragma unroll
                for (int bj = 0; bj < 2; ++bj) {
                    float v[8];
#pragma unroll
                    for (int e = 0; e < 4; ++e) { v[e] = acc[ai][bj][m][0][e]; v[4 + e] = acc[ai][bj][m][1][e]; }
                    const bool rp_here = ropew && !(pn == 2 && bj == 1) && !(pn == 10 && (bj == 1 || wc != 0));
                    if (rp_here) {
#pragma unroll
                        for (int e = 0; e < 8; ++e) {
                            const float oth = __shfl_xor(v[e], 16);
                            const float c = e < 4 ? cs0[e & 3] : cs1[e & 3], s = e < 4 ? sn0[e & 3] : sn1[e & 3];
                            const float res = v[e] * c + (fq == 0 ? -oth : oth) * s;
                            if (fq < 2) v[e] = res;
                        }
                    }
                    const int tc = bj * HALF + wc * 32 + fq * 8;
                    if (pn < 2) {
                        half8 h;
#pragma unroll
                        for (int e = 0; e < 8; ++e) h[e] = (half_t)(v[e] * qscale);
                        *(half8*)(Q + (size_t)row * 512 + pn * 256 + tc) = h;
                    } else if (pn == 2) {
                        if (bj == 0) { half8 h;
#pragma unroll
                            for (int e = 0; e < 8; ++e) h[e] = (half_t)v[e];
                            ((u32x4*)KB)[((size_t)((bb * 64 + (tt >> 5)) * 16 + (wc * 4 + fq))) * 32 + (tt & 31)] = __builtin_bit_cast(u32x4, h);
                        } else { const int vcol = tc - 128, kvh = vcol >> 6, d0 = vcol & 63;
                            half_t* vb = VT + ((size_t)(bb * 64 + (tt >> 5)) * 4608 + (size_t)(kvh * 64 + d0) * 36 + (tt & 31));
#pragma unroll
                            for (int e = 0; e < 8; ++e) vb[e * 36] = (half_t)v[e];
                        }
                    } else if (pn < 7) { half8 h;
#pragma unroll
                        for (int e = 0; e < 8; ++e) h[e] = (half_t)v[e];
                        *(half8*)(QI + (size_t)row * 1024 + (pn - 3) * 256 + tc) = h;
                    } else if (pn < 9) { half8 h;
#pragma unroll
                        for (int e = 0; e < 8; ++e) h[e] = (half_t)v[e];
                        *(half8*)(UC + (size_t)row * 512 + (pn - 7) * 256 + tc) = h;
                    } else if (pn == 9) { half8 h;
#pragma unroll
                        for (int e = 0; e < 8; ++e) h[e] = (half_t)v[e];
                        *(half8*)(UP + (size_t)row * 256 + tc) = h;
                    } else {
                        if (bj == 0) {
                            if (wc < 2) { half8 h;
#pragma unroll
                                for (int e = 0; e < 8; ++e) h[e] = (half_t)v[e];
                                const int c = wc * 4 + fq;
                                KI[((size_t)((bb * 16 + (tt >> 7)) * 8 + c)) * 128 + (tt & 127)] = __builtin_bit_cast(u32x4, h);
                            } else if (wc == 2 && fq < 2) {
                                float* wp = WI + (size_t)row * 16 + fq * 8;
                                *(f32x4*)wp = (f32x4){v[0], v[1], v[2], v[3]}; *(f32x4*)(wp + 4) = (f32x4){v[4], v[5], v[6], v[7]};
                            }
                        }
                    }
                }
                asm volatile("" ::: "memory");
            }
    }
};


template <class Epi, class Sched, bool ALIGN_EPI = false, bool SP2 = false>
__device__ __forceinline__ void gemm_phase(PG8_LAS unsigned char* lds, const Gemm g, const Sched& S, const Epi& E) {
    int tid = threadIdx.x; asm volatile("" : "+v"(tid));
    const int wid = __builtin_amdgcn_readfirstlane(tid >> 6), lane = tid & 63, wr = wid >> 2, wc = wid & 3, fr = lane & 15, fq = lane >> 4;
    const int K = g.K, nt = K / BK;
    unsigned voffA[2], voffB[2];
#pragma unroll
    for (int i = 0; i < 2; ++i) { int R, C; stage_rc(tid * 16 + i * 8192, R, C); const int Rb = Epi::PERM ? ((R & ~31) + perm32(R & 31)) : R;
        voffA[i] = (unsigned)(R * K + C) * 2u; voffB[i] = (unsigned)(Rb * K + C) * 2u; }
    const size_t kstep = (size_t)(BK * 2);
    const size_t hstep = (size_t)HALF * K * 2;
    const size_t tstep = 2 * hstep;
    const unsigned ldsw = (unsigned)wid * 1024u;
    const int aoff = lds_byte(wr * 64 + fr, fq * 8), boff = lds_byte(wc * 32 + fr, fq * 8);
#define PG8_SA(b, h) (((b) * 2 + (h)) * HTB)
#define PG8_SB(b, h) ((4 + (b) * 2 + (h)) * HTB)
#define PG8_STAGE(bufoff, gbase, voff) do { _Pragma("unroll") for (int _i = 0; _i < 2; ++_i) \
        __builtin_amdgcn_global_load_lds((const unsigned*)((const char*)(gbase) + (voff)[_i]), (PG8_LAS unsigned*)(lds + (bufoff) + ldsw + _i * 8192), 16, 0, 0); } while (0)
#define PG8_LDA(dst, b, h) do { _Pragma("unroll") for (int m = 0; m < 4; ++m) _Pragma("unroll") for (int k = 0; k < 2; ++k) dst[m][k] = *(const PG8_LAS bf16x8*)(lds + PG8_SA(b, h) + aoff + m * 2048 + k * 1024); } while (0)
#define PG8_LDB(dst, b, h) do { _Pragma("unroll") for (int n = 0; n < 2; ++n) _Pragma("unroll") for (int k = 0; k < 2; ++k) dst[n][k] = *(const PG8_LAS bf16x8*)(lds + PG8_SB(b, h) + boff + n * 2048 + k * 1024); } while (0)
#define PG8_MMA(ai, bj, At, Bt) do { __builtin_amdgcn_s_setprio(1); _Pragma("unroll") for (int m = 0; m < 4; ++m) _Pragma("unroll") for (int n = 0; n < 2; ++n) _Pragma("unroll") for (int k = 0; k < 2; ++k) \
        acc[ai][bj][m][n] = __builtin_amdgcn_mfma_f32_16x16x32_bf16(Bt[n][k], At[m][k], acc[ai][bj][m][n], 0, 0, 0); __builtin_amdgcn_s_setprio(0); } while (0)
#define PG8_WAIT_V(n) asm volatile("s_waitcnt vmcnt(" #n ")" ::: "memory")
#define PG8_WAIT_L(n) asm volatile("s_waitcnt lgkmcnt(" #n ")" ::: "memory")
#define PG8_BAR __builtin_amdgcn_s_barrier()
#define PG8_SCHED __builtin_amdgcn_sched_barrier(0)
    Unit cur, nxt; int ui = 0;
    if (!S.next(0, cur)) return;
    f32x4 acc[2][2][4][2];
#pragma unroll
    for (int a = 0; a < 2; ++a)
#pragma unroll
        for (int b = 0; b < 2; ++b)
#pragma unroll
            for (int m = 0; m < 4; ++m)
#pragma unroll
                for (int n = 0; n < 2; ++n) acc[a][b][m][n] = (f32x4){0.f, 0.f, 0.f, 0.f};
    bf16x8 At[4][2], B0[2][2], B1[2][2];
    const char* cA = (const char*)g.A + (size_t)cur.pm * tstep; const char* cB = (const char*)g.Bt + (size_t)cur.pn * tstep;
    S.a_ready(cur);
    if constexpr (SP2) {
        PG8_STAGE(PG8_SB(0, 0), cB, voffB); PG8_STAGE(PG8_SB(0, 1), cB + hstep, voffB); PG8_STAGE(PG8_SA(0, 0), cA, voffA); PG8_STAGE(PG8_SA(0, 1), cA + hstep, voffA);
        if (wr == 1) PG8_BAR;
        PG8_WAIT_V(2); PG8_BAR;
        PG8_STAGE(PG8_SB(1, 0), cB + kstep, voffB); PG8_STAGE(PG8_SA(1, 0), cA + kstep, voffA); PG8_STAGE(PG8_SB(1, 1), cB + hstep + kstep, voffB);
        PG8_WAIT_V(6); PG8_BAR;
    } else {
        PG8_STAGE(PG8_SB(0, 0), cB, voffB); PG8_STAGE(PG8_SA(0, 0), cA, voffA); PG8_STAGE(PG8_SB(0, 1), cB + hstep, voffB); PG8_STAGE(PG8_SA(0, 1), cA + hstep, voffA);
        if (wr == 1) PG8_BAR;
        PG8_WAIT_V(4); PG8_BAR;
        PG8_STAGE(PG8_SB(1, 0), cB + kstep, voffB); PG8_STAGE(PG8_SA(1, 0), cA + kstep, voffA); PG8_STAGE(PG8_SB(1, 1), cB + hstep + kstep, voffB);
        PG8_WAIT_V(6); PG8_BAR;
    }
    for (;;) {
        const bool has_next = S.next(ui + 1, nxt);
        const char* nA = has_next ? (const char*)g.A + (size_t)nxt.pm * tstep : cA; const char* nB = has_next ? (const char*)g.Bt + (size_t)nxt.pn * tstep : cB;
        for (int t = 0; t < nt; t += 2) {
            const bool last = (t == nt - 2);
            const char* a1 = cA + (size_t)(t + 1) * kstep;
            const char* a2 = last ? nA : cA + (size_t)(t + 2) * kstep; const char* b2 = last ? nB : cB + (size_t)(t + 2) * kstep;
            const char* a3 = a2 + kstep; const char* b3 = b2 + kstep;
            if (last && has_next) S.a_ready(nxt);
            if constexpr (SP2) {
            PG8_LDB(B0, 0, 0); PG8_LDB(B1, 0, 1); PG8_SCHED; PG8_LDA(At, 0, 0); PG8_STAGE(PG8_SA(1, 1), a1 + hstep, voffA);
            PG8_WAIT_V(8); PG8_WAIT_L(0); PG8_BAR; PG8_MMA(0, 0, At, B0); PG8_MMA(0, 1, At, B1); PG8_BAR; PG8_SCHED;
            PG8_LDA(At, 0, 1); PG8_STAGE(PG8_SB(0, 0), b2, voffB); PG8_STAGE(PG8_SB(0, 1), b2 + hstep, voffB); PG8_STAGE(PG8_SA(0, 0), a2, voffA);
            PG8_WAIT_V(8); PG8_WAIT_L(0); PG8_BAR; PG8_MMA(1, 0, At, B0); PG8_MMA(1, 1, At, B1); PG8_BAR; PG8_SCHED;
            PG8_LDB(B0, 1, 0); PG8_LDB(B1, 1, 1); PG8_SCHED; PG8_LDA(At, 1, 0); PG8_STAGE(PG8_SA(0, 1), a2 + hstep, voffA);
            PG8_WAIT_V(8); PG8_WAIT_L(0); PG8_BAR; PG8_MMA(0, 0, At, B0); PG8_MMA(0, 1, At, B1); PG8_BAR; PG8_SCHED;
            PG8_LDA(At, 1, 1); PG8_STAGE(PG8_SB(1, 0), b3, voffB); PG8_STAGE(PG8_SB(1, 1), b3 + hstep, voffB); PG8_STAGE(PG8_SA(1, 0), a3, voffA);
            PG8_WAIT_V(8); PG8_WAIT_L(0); PG8_BAR; PG8_MMA(1, 0, At, B0); PG8_MMA(1, 1, At, B1); PG8_BAR; PG8_SCHED;
            } else {
            PG8_LDB(B0, 0, 0); PG8_SCHED; PG8_LDA(At, 0, 0); PG8_STAGE(PG8_SA(1, 1), a1 + hstep, voffA);
            PG8_WAIT_L(8); PG8_BAR; PG8_WAIT_L(0); PG8_MMA(0, 0, At, B0); PG8_BAR; PG8_SCHED;
            PG8_LDB(B1, 0, 1); PG8_STAGE(PG8_SB(0, 0), b2, voffB);
            PG8_BAR; PG8_WAIT_L(0); PG8_MMA(0, 1, At, B1); PG8_BAR;
            PG8_LDA(At, 0, 1); PG8_STAGE(PG8_SA(0, 0), a2, voffA);
            PG8_BAR; PG8_WAIT_L(0); PG8_MMA(1, 0, At, B0); PG8_BAR; PG8_SCHED;
            PG8_STAGE(PG8_SB(0, 1), b2 + hstep, voffB);
            PG8_WAIT_V(6); PG8_BAR; PG8_MMA(1, 1, At, B1); PG8_BAR;
            PG8_LDB(B0, 1, 0); PG8_SCHED; PG8_LDA(At, 1, 0); PG8_STAGE(PG8_SA(0, 1), a2 + hstep, voffA);
            PG8_WAIT_L(8); PG8_BAR; PG8_WAIT_L(0); PG8_MMA(0, 0, At, B0); PG8_BAR; PG8_SCHED;
            PG8_LDB(B1, 1, 1); PG8_STAGE(PG8_SB(1, 0), b3, voffB);
            PG8_BAR; PG8_WAIT_L(0); PG8_MMA(0, 1, At, B1); PG8_BAR;
            PG8_LDA(At, 1, 1); PG8_STAGE(PG8_SA(1, 0), a3, voffA);
            PG8_BAR; PG8_WAIT_L(0); PG8_MMA(1, 0, At, B0); PG8_BAR; PG8_SCHED;
            PG8_STAGE(PG8_SB(1, 1), b3 + hstep, voffB);
            PG8_WAIT_V(6); PG8_BAR; PG8_MMA(1, 1, At, B1); PG8_BAR;
            }
        }
        if constexpr (ALIGN_EPI) { if (wr == 0) PG8_BAR; }
        if constexpr (!Epi::AFTER_DRAIN) { E(acc, cur, wr, wc, fr, fq); S.done(cur); }
        if (!has_next) break;
#pragma unroll
        for (int a = 0; a < 2; ++a)
#pragma unroll
            for (int b = 0; b < 2; ++b)
#pragma unroll
                for (int m = 0; m < 4; ++m)
#pragma unroll
                    for (int n = 0; n < 2; ++n) acc[a][b][m][n] = (f32x4){0.f, 0.f, 0.f, 0.f};
        cur = nxt; cA = nA; cB = nB; ++ui;
        if constexpr (ALIGN_EPI) { if (wr == 1) PG8_BAR; }
    }
    PG8_WAIT_V(0);
    if constexpr (!ALIGN_EPI) { if (wr == 0) PG8_BAR; }
    PG8_BAR;
    if constexpr (Epi::AFTER_DRAIN) { E.fused(acc, cur, wr, wc, fr, fq, lds, wid, lane); S.done(cur); }
#undef PG8_SA
#undef PG8_SB
#undef PG8_STAGE
#undef PG8_LDA
#undef PG8_LDB
#undef PG8_MMA
#undef PG8_WAIT_V
#undef PG8_WAIT_L
#undef PG8_BAR
#undef PG8_SCHED
}
}
#define GAS __attribute__((address_space(1)))
#define LAS __attribute__((address_space(3)))
typedef unsigned short bf16;
typedef unsigned v4u __attribute__((ext_vector_type(4)));
typedef float f32x4 __attribute__((ext_vector_type(4)));
typedef short bf16x8 __attribute__((ext_vector_type(8)));
typedef GAS unsigned gu32;
typedef GAS unsigned long long gu64;
#define RLX_AGENT __ATOMIC_RELAXED, __HIP_MEMORY_SCOPE_AGENT
#define LDS_WAIT() asm volatile("s_waitcnt lgkmcnt(0)" ::: "memory")
#define VM_WAIT() asm volatile("s_waitcnt vmcnt(0)" ::: "memory")
__device__ __forceinline__ unsigned long long rt() { return __builtin_amdgcn_s_memrealtime(); }
__device__ __forceinline__ unsigned f2bf(float f) { unsigned u = __builtin_bit_cast(unsigned, f); return (u + 0x7fffu + ((u >> 16) & 1u)) >> 16; }
__device__ __forceinline__ unsigned pk2(float lo, float hi) { return f2bf(lo) | (f2bf(hi) << 16); }

#define XB_TMO      128
#define XB_XCNT(j)  (256  + 64 * (j))
#define XB_XSUB(j)  (1280 + 64 * (j))
#define XB_XGEN(j)  (2304 + 64 * (j))
#define XB_TOP      3328
#define XB_TOPGEN   3392
#define XCD_BAR_WORDS 3456
#define XB_SPIN_CAP (1u << 18)

__device__ __forceinline__ unsigned xb_ld(unsigned* p)              { return __hip_atomic_load(p, __ATOMIC_RELAXED, __HIP_MEMORY_SCOPE_AGENT); }
__device__ __forceinline__ unsigned xb_add(unsigned* p, unsigned v) { return __hip_atomic_fetch_add(p, v, __ATOMIC_RELAXED, __HIP_MEMORY_SCOPE_AGENT); }
__device__ __forceinline__ unsigned xb_xcc_id() { return (unsigned)__builtin_amdgcn_s_getreg((3 << 11) | 20) & 0xFu; }
#define XB_SPIN(cond, bar) do { unsigned _sp = 0; while (cond) { __builtin_amdgcn_s_sleep(1); \
    if ((++_sp & 255u) == 0u) { if (xb_ld(&(bar)[XB_TMO])) break; if (_sp > XB_SPIN_CAP) { atomicAdd(&(bar)[XB_TMO], 1u); break; } } } } while (0)

struct XcdBarrier {
    unsigned* bar; unsigned x;
    volatile LAS unsigned* st;
};

__device__ __forceinline__ XcdBarrier xcd_barrier_post(unsigned* bar, volatile LAS unsigned* st) {
    XcdBarrier b; b.bar = bar; b.x = xb_xcc_id(); b.st = st;
    if (threadIdx.x == 0) (void)xb_add(&bar[XB_XCNT(b.x)], 1u);
    return b;
}
__device__ __forceinline__ void xcd_barrier_complete(unsigned* bar, unsigned x, unsigned& nloc, unsigned& nx) {
    const unsigned G = gridDim.x * gridDim.y * gridDim.z;
    unsigned sum, cnt, mine, sp = 0u;
    for (;;) {
        sum = 0u; cnt = 0u; mine = 0u;
#pragma unroll
        for (unsigned j = 0; j < 16; ++j) { const unsigned c = xb_ld(&bar[XB_XCNT(j)]); sum += c; cnt += (c > 0u) ? 1u : 0u; mine = (j == x) ? c : mine; }
        if (sum == G) break;
        __builtin_amdgcn_s_sleep(1);
        if ((++sp & 255u) == 0u) { if (xb_ld(&bar[XB_TMO])) break; if (sp > XB_SPIN_CAP) { atomicAdd(&bar[XB_TMO], 1u); break; } }
    }
    nloc = mine > 0u ? mine : 1u; nx = cnt > 0u ? cnt : 1u;
}

__device__ __forceinline__ void xcd_barrier(const XcdBarrier& b) {
    asm volatile("s_waitcnt vmcnt(0)" ::: "memory");
    __syncthreads();
    if (threadIdx.x == 0) {
        unsigned* bar = b.bar;
        __builtin_amdgcn_s_waitcnt(0);
        unsigned nloc = b.st[0], nx = b.st[1];
        if (nloc == 0u) { xcd_barrier_complete(bar, b.x, nloc, nx); b.st[0] = nloc; b.st[1] = nx; }
        const unsigned old = xb_add(&bar[XB_XSUB(b.x)], 1u);
        const unsigned gen = old / nloc;
        if (old + 1u == (gen + 1u) * nloc) {
            __builtin_amdgcn_fence(__ATOMIC_RELEASE, "agent");
            asm volatile("s_waitcnt vmcnt(0)" ::: "memory");
            const unsigned og = xb_add(&bar[XB_TOP], 1u);
            const unsigned tg = og / nx;
            if (og + 1u == (tg + 1u) * nx) xb_add(&bar[XB_TOPGEN], 1u);
            else XB_SPIN(xb_ld(&bar[XB_TOPGEN]) == tg, bar);
            __builtin_amdgcn_fence(__ATOMIC_ACQUIRE, "agent");
            xb_add(&bar[XB_XGEN(b.x)], 1u);
            asm volatile("s_waitcnt vmcnt(0)" ::: "memory");
        } else {
            XB_SPIN(xb_ld(&bar[XB_XGEN(b.x)]) == gen, bar);
            __builtin_amdgcn_fence(__ATOMIC_ACQUIRE, "agent");
            asm volatile("s_waitcnt vmcnt(0)" ::: "memory");
        }
    }
    __syncthreads();
}

constexpr int NB = 8, SEQ = 2048, DM = 1024, FF = 4096, NLAYER = 2, PLE_DIM = 256, NIN = 2816;
constexpr int M = NB * SEQ;
constexpr float NORM_EPS = 1e-6f, LN_EPS = 1e-5f;
constexpr float QSCALE = 0.125f * 1.4426950408889634f;
constexpr int NWAVES = 8;
constexpr int PH_PER_LAYER = 9, NPHASE = NLAYER * PH_PER_LAYER;
#ifndef MK_N_LAUNCHES
#define MK_N_LAUNCHES 1
#endif
constexpr int N_LAUNCHES = MK_N_LAUNCHES;

constexpr size_t MiB = 1u << 20;
constexpr size_t WS_CTL = 0, CTL_ZERO_BYTES = 1 * MiB;
constexpr size_t WS_WIN = 1 * MiB, WS_WOUT = 7 * MiB, WS_WUP = 9 * MiB, WS_WDN = 17 * MiB, WS_WGATE = 25 * MiB, WS_WPLE = 27 * MiB, WS_WCPW = 27 * MiB + 512 * 1024, WS_WPOOL = 27 * MiB + 768 * 1024;
constexpr size_t WS_ROPE = 28 * MiB, WS_P = 29 * MiB, WS_XN = 37 * MiB, WS_Y = 69 * MiB, WS_BIG = 101 * MiB;
constexpr size_t WS_HD = WS_BIG;
constexpr size_t WS_Q = 101 * MiB, WS_QI = 117 * MiB, WS_UC = 149 * MiB, WS_UP = 165 * MiB, WS_KB = 173 * MiB  , WS_VT = 177 * MiB  , WS_KI = 182 * MiB, WS_WI = 184 * MiB, WS_MIX = 185 * MiB;
constexpr size_t WS_END = 229 * MiB;
static_assert(WS_WIN + (size_t)NIN * DM * 2 <= WS_WOUT && WS_MIX + (size_t)M * DM * 2 <= WS_END && WS_HD + (size_t)M * FF * 2 <= WS_END, "d_ws map");
constexpr int CW_TMO = 0, CW_CODE = 1, CW_BAR = 4096;
constexpr int RING_BYTES = 131072, LDSCTL_OFF = RING_BYTES, MISC_OFF = LDSCTL_OFF + 320, LDS_BYTES = 147456;

__device__ __forceinline__ float wave_sum(float v) {
#pragma unroll
    for (int o = 1; o < 64; o <<= 1) v += __shfl_xor(v, o);
    return v;
}
__device__ __forceinline__ float bf_lo(unsigned w) { return __uint_as_float(w << 16); }
__device__ __forceinline__ float bf_hi(unsigned w) { return __uint_as_float(w & 0xffff0000u); }
typedef unsigned u32x2 __attribute__((ext_vector_type(2)));
typedef _Float16 half_t;
typedef _Float16 half8 __attribute__((ext_vector_type(8)));
typedef _Float16 half4 __attribute__((ext_vector_type(4)));
typedef float f32x16 __attribute__((ext_vector_type(16)));

__device__ __forceinline__ void sincos_acc(float ang, float& c, float& s) {
    const double a = (double)ang;
    const double q = __builtin_rint(a * 0.63661977236758134308);
    const double r = (a - q * 1.57079632679489655800) - q * 6.12323399573676603587e-17;
    const int n = ((int)q) & 3;
    const double r2 = r * r;
    const double sp = r * (1.0 + r2 * (-1.0 / 6 + r2 * (1.0 / 120 + r2 * (-1.0 / 5040 + r2 * (1.0 / 362880 + r2 * (-1.0 / 39916800 + r2 * (1.0 / 6227020800.0)))))));
    const double cp = 1.0 + r2 * (-0.5 + r2 * (1.0 / 24 + r2 * (-1.0 / 720 + r2 * (1.0 / 40320 + r2 * (-1.0 / 3628800 + r2 * (1.0 / 479001600.0 + r2 * (-1.0 / 87178291200.0)))))));
    const double sv = (n == 0) ? sp : (n == 1) ? cp : (n == 2) ? -sp : -cp;
    const double cv = (n == 0) ? cp : (n == 1) ? -sp : (n == 2) ? -cp : sp;
    c = (float)cv; s = (float)sv;
}

__device__ __forceinline__ void tr_item(const float* W, int K, int N, int scol, int nvalid, bf16* WT, int drow, int k0, LAS float* scr, int lane) {
    const int n = lane & 31;
#pragma unroll 8
    for (int i = 0; i < 32; ++i) { const int kk = 2 * i + (lane >> 5); scr[kk * 33 + n] = (n < nvalid) ? W[(size_t)(k0 + kk) * N + scol + n] : 0.f; }
    LDS_WAIT(); asm volatile("" ::: "memory");
    const int c = lane & 7;
#pragma unroll
    for (int j = 0; j < 4; ++j) { const int nn = (lane >> 3) + 8 * j; const LAS float* s = scr + (8 * c) * 33 + nn;
        v4u o; o.x = pk2(s[0 * 33], s[1 * 33]); o.y = pk2(s[2 * 33], s[3 * 33]); o.z = pk2(s[4 * 33], s[5 * 33]); o.w = pk2(s[6 * 33], s[7 * 33]);
        *(GAS v4u*)(WT + (size_t)(drow + nn) * K + k0 + 8 * c) = o; }
    LDS_WAIT(); asm volatile("" ::: "memory");
}

__device__ __forceinline__ void t0_row(const float* src, float* dstcopy, const float* g, bf16* xn, int lane) {
    const f32x4* xr = (const f32x4*)src + lane;
    f32x4 v[4]; float s = 0.f;
#pragma unroll
    for (int j = 0; j < 4; ++j) { v[j] = xr[64 * j]; s += (v[j].x * v[j].x + v[j].y * v[j].y) + (v[j].z * v[j].z + v[j].w * v[j].w); }
    if (dstcopy) {
#pragma unroll
        for (int j = 0; j < 4; ++j) ((f32x4*)dstcopy + lane)[64 * j] = v[j]; }
    const float rs = 1.0f / sqrtf(wave_sum(s) * (1.f / DM) + NORM_EPS);
    unsigned long long* o8 = (unsigned long long*)xn + lane;
#pragma unroll
    for (int j = 0; j < 4; ++j) { const f32x4 gv = ((const f32x4*)g + lane)[64 * j];
        o8[64 * j] = (unsigned long long)pk2(v[j].x * rs * gv.x, v[j].y * rs * gv.y) | ((unsigned long long)pk2(v[j].z * rs * gv.z, v[j].w * rs * gv.w) << 32); }
}
__device__ __forceinline__ void tres_row(const bf16* y, const float* gpost, float* h, const float* gnext, bf16* xn, int lane) {
    f32x4 yv[4], hv[4]; float s = 0.f;
#pragma unroll
    for (int j = 0; j < 4; ++j) { const u32x2 w = ((const u32x2*)y)[lane + 64 * j]; yv[j] = (f32x4){bf_lo(w.x), bf_hi(w.x), bf_lo(w.y), bf_hi(w.y)};
        s += (yv[j].x * yv[j].x + yv[j].y * yv[j].y) + (yv[j].z * yv[j].z + yv[j].w * yv[j].w); }
    const float rs = 1.0f / sqrtf(wave_sum(s) * (1.f / DM) + NORM_EPS);
    float s2 = 0.f;
#pragma unroll
    for (int j = 0; j < 4; ++j) { const f32x4 gp = ((const f32x4*)gpost + lane)[64 * j]; hv[j] = ((const f32x4*)h + lane)[64 * j];
        hv[j].x += yv[j].x * rs * gp.x; hv[j].y += yv[j].y * rs * gp.y; hv[j].z += yv[j].z * rs * gp.z; hv[j].w += yv[j].w * rs * gp.w;
        ((f32x4*)h + lane)[64 * j] = hv[j];
        s2 += (hv[j].x * hv[j].x + hv[j].y * hv[j].y) + (hv[j].z * hv[j].z + hv[j].w * hv[j].w); }
    unsigned long long* o8 = (unsigned long long*)xn + lane;
    if (gnext) {
        const float rs2 = 1.0f / sqrtf(wave_sum(s2) * (1.f / DM) + NORM_EPS);
#pragma unroll
        for (int j = 0; j < 4; ++j) { const f32x4 gv = ((const f32x4*)gnext + lane)[64 * j];
            o8[64 * j] = (unsigned long long)pk2(hv[j].x * rs2 * gv.x, hv[j].y * rs2 * gv.y) | ((unsigned long long)pk2(hv[j].z * rs2 * gv.z, hv[j].w * rs2 * gv.w) << 32); }
    } else {
#pragma unroll
        for (int j = 0; j < 4; ++j) o8[64 * j] = (unsigned long long)pk2(hv[j].x, hv[j].y) | ((unsigned long long)pk2(hv[j].z, hv[j].w) << 32);
    }
}

__device__ __forceinline__ float xmax4(float m) {
    auto r = __builtin_amdgcn_permlane16_swap(__float_as_uint(m), __float_as_uint(m), false, false);
    const float a = fmaxf(__uint_as_float(r[0]), __uint_as_float(r[1]));
    auto r2 = __builtin_amdgcn_permlane32_swap(__float_as_uint(a), __float_as_uint(a), false, false);
    return fmaxf(__uint_as_float(r2[0]), __uint_as_float(r2[1]));
}
__device__ __forceinline__ void attn_unit(LAS unsigned char* lds, int b, int ut, const half_t* Q, const v4u* KIMG, const v4u* VIMG, const half_t* QI, const v4u* KI, const float* WI, bf16* MIX, int tid, int lane, int w) {
    asm volatile("" : "+v"(tid)); lane = tid & 63;
    LAS v4u* kist = (LAS v4u*)lds;
    LAS unsigned* maskl = (LAS unsigned*)(lds + 32768);
    LAS v4u* ktl = (LAS v4u*)(lds + 40960);
    LAS unsigned char* vtl = lds + 57344;
    const int t0 = ut * 32; const size_t rowbase = (size_t)b * SEQ;
    const int hi = lane >> 5, j32 = lane & 31;
#pragma unroll 1
    for (int ip = 0; ip < 2; ++ip) {
        const int tb = t0 + 16 * ip;
        const int tq = tb + 2 * w + hi, tq1 = tb + 2 * w + 1;
        const int ng = (tq1 >> 5) + 1;
        const int nch = ((tb + 15) >> 7) + 1;
        unsigned mlo = 0u, mhi = 0u;
        half8 aq[4];
        { const int qsel = (j32 >> 2) & 1, head = (j32 & 3) + 4 * (j32 >> 3);
          const half_t* qrow = QI + (rowbase + tb + 2 * w + qsel) * 1024 + head * 64 + 8 * hi;
#pragma unroll
          for (int d0 = 0; d0 < 4; ++d0) aq[d0] = *(const half8*)(qrow + 16 * d0); }
        float wv[16];
        { const f32x4* wp = (const f32x4*)(WI + (rowbase + tq) * 16);
#pragma unroll
          for (int k = 0; k < 4; ++k) { const f32x4 x = wp[k]; wv[4 * k] = x.x; wv[4 * k + 1] = x.y; wv[4 * k + 2] = x.z; wv[4 * k + 3] = x.w; } }
        float sc[64];
#pragma unroll
        for (int g = 0; g < 64; ++g) sc[g] = -INFINITY;
        const GAS v4u* kig = (const GAS v4u*)(KI + (size_t)(b * 16) * 1024) + tid;
        v4u x0 = kig[0], x1 = kig[512];
        __syncthreads();
        kist[tid] = x0; kist[tid + 512] = x1;
#pragma unroll
        for (int kc = 0; kc < 16; ++kc) {
            if (kc < nch) {
                if (kc + 1 < nch) { const GAS v4u* src = kig + (kc + 1) * 1024; asm volatile("" : "+v"(src)); x0 = src[0]; x1 = src[512]; }
                __syncthreads();
                LAS v4u* kb = kist + (kc & 1) * 1024;
#pragma unroll
                for (int gg = 0; gg < 4; ++gg) {
                    const int g = kc * 4 + gg;
                    if (g < ng) {
                        f32x16 acc = {0.f, 0.f, 0.f, 0.f, 0.f, 0.f, 0.f, 0.f, 0.f, 0.f, 0.f, 0.f, 0.f, 0.f, 0.f, 0.f};
#pragma unroll
                        for (int d0 = 0; d0 < 4; ++d0) { const half8 bk = __builtin_bit_cast(half8, kb[(2 * d0 + hi) * 128 + gg * 32 + j32]);
                            acc = __builtin_amdgcn_mfma_f32_32x32x16_f16(aq[d0], bk, acc, 0, 0, 0); }
                        float s = 0.f;
#pragma unroll
                        for (int r = 0; r < 16; ++r) s += wv[r] * fmaxf(acc[r], 0.f);
                        sc[g] = s;
                    }
                }
                if (kc + 1 < nch) { LAS v4u* kn = kist + ((kc + 1) & 1) * 1024; kn[tid] = x0; kn[tid + 512] = x1; }
            }
        }
        unsigned uk[64];
#pragma unroll
        for (int g = 0; g < 64; ++g) { const unsigned bts = __float_as_uint(sc[g]); const unsigned kk = (bts & 0x80000000u) ? ~bts : (bts | 0x80000000u);
            uk[g] = (32 * g + j32 <= tq) ? kk : 0u; }
        unsigned thr = 0u; bool done = false;
        if (tq + 1 <= 256) { thr = 1u; done = true; }
        for (int bit = 31; bit >= 0; --bit) {
            if (__all(done)) break;
            const unsigned cand = thr | (1u << bit);
            unsigned cnt = 0u;
#pragma unroll
            for (int blk = 0; blk < 8; ++blk) if (blk * 8 < ng) {
#pragma unroll
                for (int k = 0; k < 8; ++k) cnt += (uk[blk * 8 + k] >= cand) ? 1u : 0u; }
            cnt += (unsigned)__builtin_amdgcn_update_dpp(0, (int)cnt, 0xB1, 0xF, 0xF, true);
            cnt += (unsigned)__builtin_amdgcn_update_dpp(0, (int)cnt, 0x4E, 0xF, 0xF, true);
            cnt += (unsigned)__builtin_amdgcn_update_dpp(0, (int)cnt, 0x141, 0xF, 0xF, true);
            cnt += (unsigned)__builtin_amdgcn_update_dpp(0, (int)cnt, 0x140, 0xF, 0xF, true);
            const unsigned c0 = (unsigned)__builtin_amdgcn_readlane((int)cnt, 0) + (unsigned)__builtin_amdgcn_readlane((int)cnt, 16);
            const unsigned c1 = (unsigned)__builtin_amdgcn_readlane((int)cnt, 32) + (unsigned)__builtin_amdgcn_readlane((int)cnt, 48);
            const unsigned ch = hi ? c1 : c0;
            if (!done && ch >= 256u) thr = cand;
            if (ch == 256u) done = true;
        }
#define WL1(g) if ((g) < ng) { const unsigned long long bal = __ballot(uk[g] >= thr); \
            asm volatile("s_nop 4\n\tv_writelane_b32 %0, %2, " #g "\n\ts_nop 1\n\tv_writelane_b32 %1, %3, " #g "\n\ts_nop 1" : "+v"(mlo), "+v"(mhi) : "s"((unsigned)bal), "s"((unsigned)(bal >> 32))); }
#define WL8(a) WL1(a) WL1(a + 1) WL1(a + 2) WL1(a + 3) WL1(a + 4) WL1(a + 5) WL1(a + 6) WL1(a + 7)
        WL8(0) WL8(8) WL8(16) WL8(24) WL8(32) WL8(40) WL8(48) WL8(56)
#undef WL8
#undef WL1
        maskl[(16 * ip + 2 * w) * 64 + lane] = mlo; maskl[(16 * ip + 2 * w + 1) * 64 + lane] = mhi;
    }
    {
        const int col = lane & 15, g4 = lane >> 4, r16 = lane & 15;
        const int kvh = w >> 2, wq = w & 3;
        const int hq = kvh * 4 + (col & 3);
        half8 bq[2][2];
#pragma unroll
        for (int cg = 0; cg < 2; ++cg) { const half_t* qp = Q + (rowbase + t0 + 8 * wq + 4 * cg + (col >> 2)) * 512 + hq * 64 + 8 * g4; bq[cg][0] = *(const half8*)qp; bq[cg][1] = *(const half8*)(qp + 32); }
        const int ntile = (t0 >> 5) + 1;
        float mrun[2] = {-INFINITY, -INFINITY}, lrun[2] = {0.f, 0.f};
        f32x4 o[2][4];
#pragma unroll
        for (int cg = 0; cg < 2; ++cg)
#pragma unroll
            for (int d = 0; d < 4; ++d) o[cg][d] = (f32x4){0.f, 0.f, 0.f, 0.f};
        const GAS v4u* kg = (const GAS v4u*)(KIMG + (size_t)(b * 64) * 512) + tid;
        const GAS v4u* vg = (const GAS v4u*)(VIMG + (size_t)(b * 64) * 576) + tid;
        v4u kx = kg[0], vx0 = vg[0], vx1 = {0u, 0u, 0u, 0u};
        if (tid < 64) vx1 = vg[512];
        __syncthreads();
        ktl[tid] = kx; ((LAS v4u*)vtl)[tid] = vx0; if (tid < 64) ((LAS v4u*)vtl)[512 + tid] = vx1;
        const LAS unsigned* mq0 = maskl + (8 * wq + (col >> 2)) * 64;
#pragma unroll 1
        for (int kt = 0; kt < ntile; ++kt) {
            if (kt + 1 < ntile) { const GAS v4u* ks = kg + (size_t)(kt + 1) * 512; const GAS v4u* vs = vg + (size_t)(kt + 1) * 576; kx = ks[0]; vx0 = vs[0]; if (tid < 64) vx1 = vs[512]; }
            __syncthreads();
            const LAS v4u* kb = ktl + (kt & 1) * 512 + (kvh * 8 + g4) * 32 + r16;
            const LAS unsigned char* vb_ = vtl + (kt & 1) * 9216 + (kvh * 64 + r16) * 72 + 8 * g4;
            const half8 ka00 = __builtin_bit_cast(half8, kb[0]), ka01 = __builtin_bit_cast(half8, kb[4 * 32]);
            const half8 ka10 = __builtin_bit_cast(half8, kb[16]), ka11 = __builtin_bit_cast(half8, kb[4 * 32 + 16]);
            half4 va[4], vb[4];
#pragma unroll
            for (int d = 0; d < 4; ++d) { va[d] = *(const LAS half4*)(vb_ + d * 16 * 72); vb[d] = *(const LAS half4*)(vb_ + d * 16 * 72 + 32); }
#pragma unroll
            for (int cg = 0; cg < 2; ++cg) {
                const f32x4 z4 = {0.f, 0.f, 0.f, 0.f};
                f32x4 s0 = __builtin_amdgcn_mfma_f32_16x16x32_f16(ka00, bq[cg][0], z4, 0, 0, 0); s0 = __builtin_amdgcn_mfma_f32_16x16x32_f16(ka01, bq[cg][1], s0, 0, 0, 0);
                f32x4 s1 = __builtin_amdgcn_mfma_f32_16x16x32_f16(ka10, bq[cg][0], z4, 0, 0, 0); s1 = __builtin_amdgcn_mfma_f32_16x16x32_f16(ka11, bq[cg][1], s1, 0, 0, 0);
                const unsigned mw = mq0[cg * 4 * 64 + kt];
                const unsigned b0 = mw >> (4 * g4), b1 = mw >> (16 + 4 * g4);
                float x[8];
#pragma unroll
                for (int i = 0; i < 4; ++i) { x[i] = ((b0 >> i) & 1u) ? s0[i] : -INFINITY; x[4 + i] = ((b1 >> i) & 1u) ? s1[i] : -INFINITY; }
                float mt = fmaxf(fmaxf(fmaxf(x[0], x[1]), fmaxf(x[2], x[3])), fmaxf(fmaxf(x[4], x[5]), fmaxf(x[6], x[7])));
                mt = xmax4(mt);
                const float mnew = fmaxf(mrun[cg], mt);
                const float msafe = (mnew == -INFINITY) ? 0.f : mnew;
                const float alpha = __builtin_amdgcn_exp2f(mrun[cg] - msafe);
                float p[8], ps = 0.f;
#pragma unroll
                for (int e = 0; e < 8; ++e) { p[e] = __builtin_amdgcn_exp2f(x[e] - msafe); ps += p[e]; }
                lrun[cg] = lrun[cg] * alpha + ps; mrun[cg] = mnew;
                half8 pb;
#pragma unroll
                for (int e = 0; e < 8; ++e) pb[e] = (half_t)p[e];
#pragma unroll
                for (int d = 0; d < 4; ++d) { o[cg][d] = o[cg][d] * alpha;
                    const half8 v8 = {va[d][0], va[d][1], va[d][2], va[d][3], vb[d][0], vb[d][1], vb[d][2], vb[d][3]};
                    o[cg][d] = __builtin_amdgcn_mfma_f32_16x16x32_f16(v8, pb, o[cg][d], 0, 0, 0); }
            }
            if (kt + 1 < ntile) { const int nb = (kt + 1) & 1; ktl[nb * 512 + tid] = kx; ((LAS v4u*)(vtl + nb * 9216))[tid] = vx0; if (tid < 64) ((LAS v4u*)(vtl + nb * 9216))[512 + tid] = vx1; }
        }
#pragma unroll
        for (int cg = 0; cg < 2; ++cg) {
            float lt = lrun[cg] + __shfl_xor(lrun[cg], 16); lt += __shfl_xor(lt, 32);
            const float inv = 1.0f / lt;
            bf16* op = MIX + (rowbase + t0 + 8 * wq + 4 * cg + (col >> 2)) * 1024 + hq * 64 + 4 * g4;
#pragma unroll
            for (int d = 0; d < 4; ++d) { u32x2 wv2; wv2.x = pk2(o[cg][d][0] * inv, o[cg][d][1] * inv); wv2.y = pk2(o[cg][d][2] * inv, o[cg][d][3] * inv); *(u32x2*)(op + 16 * d) = wv2; }
        }
    }
    __syncthreads();
}

__device__ __forceinline__ void conv_unit(LAS unsigned char* lds, int tok0, const half_t* UC, const float* dw, const float* cb, const float* lng, const float* lnb, const bf16* WT, bf16* MIX, int tid, int lane, int w) {
    LAS float* yl = (LAS float*)lds;
    LAS float* zl = (LAS float*)(lds + 62 * 256 * 4);
    LAS bf16* act = (LAS bf16*)(lds + 62 * 256 * 4 + 32 * 256 * 4);
    const int ts = tok0 & (SEQ - 1); const size_t rowb = (size_t)(tok0 - ts);
    for (int task = tid; task < 62 * 32; task += NWAVES * 64) {
        const int r = task >> 5, c8 = (task & 31) * 8, tp = ts - 30 + r;
        f32x4 y0 = {0.f, 0.f, 0.f, 0.f}, y1 = y0;
        if (tp >= 0) { const half_t* up = UC + (rowb + tp) * 512 + c8; const half8 a = *(const half8*)up, g = *(const half8*)(up + 256);
            float yy[8];
#pragma unroll
            for (int e = 0; e < 8; ++e) yy[e] = (float)a[e] * __builtin_amdgcn_rcpf(1.f + __builtin_amdgcn_exp2f(-1.4426950408889634f * (float)g[e]));
            y0 = (f32x4){yy[0], yy[1], yy[2], yy[3]}; y1 = (f32x4){yy[4], yy[5], yy[6], yy[7]}; }
        *(LAS f32x4*)(yl + r * 256 + c8) = y0; *(LAS f32x4*)(yl + r * 256 + c8 + 4) = y1;
    }
    __syncthreads();
    { const int c = tid & 255, th = tid >> 8;
      float dwr[31];
#pragma unroll
      for (int j = 0; j < 31; ++j) dwr[j] = dw[j * 256 + c];
      const float bias = cb[c];
      float yw[31];
#pragma unroll
      for (int it = 0; it < 46; ++it) {
          yw[it % 31] = yl[(16 * th + it) * 256 + c];
          if (it >= 30) { float z = bias;
#pragma unroll
              for (int j = 0; j < 31; ++j) z += dwr[j] * yw[(it - 30 + j) % 31];
              zl[(16 * th + it - 30) * 256 + c] = z; }
      } }
    __syncthreads();
#pragma unroll
    for (int q = 0; q < 4; ++q) { const int tok = 4 * w + q;
        const f32x4 z = *(const LAS f32x4*)(zl + tok * 256 + 4 * lane);
        const float mean = wave_sum((z.x + z.y) + (z.z + z.w)) * (1.f / 256);
        const f32x4 d = z - mean;
        const float var = wave_sum((d.x * d.x + d.y * d.y) + (d.z * d.z + d.w * d.w)) * (1.f / 256);
        const float rstd = 1.0f / sqrtf(var + LN_EPS);
        const f32x4 gv = *(const f32x4*)(lng + 4 * lane), bv = *(const f32x4*)(lnb + 4 * lane);
        float yy[4];
#pragma unroll
        for (int e = 0; e < 4; ++e) { const float t = d[e] * rstd * gv[e] + bv[e]; yy[e] = t * __builtin_amdgcn_rcpf(1.f + __builtin_amdgcn_exp2f(-1.4426950408889634f * t)); }
        u32x2 pw; pw.x = pk2(yy[0], yy[1]); pw.y = pk2(yy[2], yy[3]);
        *(LAS u32x2*)(act + tok * 264 + 4 * lane) = pw;
    }
    __syncthreads();
    { const int r16 = lane & 15, g4 = lane >> 4;
#pragma unroll
      for (int q = 0; q < 2; ++q) { const int nt = 2 * w + q;
          f32x4 a0 = {0.f, 0.f, 0.f, 0.f}, a1 = a0;
#pragma unroll
          for (int kb = 0; kb < 8; ++kb) {
              const bf16x8 wf = *(const bf16x8*)(WT + (size_t)(nt * 16 + r16) * 256 + kb * 32 + 8 * g4);
              const bf16x8 x0 = *(const LAS bf16x8*)(act + r16 * 264 + kb * 32 + 8 * g4), x1 = *(const LAS bf16x8*)(act + (16 + r16) * 264 + kb * 32 + 8 * g4);
              a0 = __builtin_amdgcn_mfma_f32_16x16x32_bf16(wf, x0, a0, 0, 0, 0); a1 = __builtin_amdgcn_mfma_f32_16x16x32_bf16(wf, x1, a1, 0, 0, 0);
          }
          bf16* o0 = MIX + (size_t)(tok0 + r16) * 1024 + 512 + nt * 16 + 4 * g4; bf16* o1 = o0 + (size_t)16 * 1024;
          u32x2 p0, p1; p0.x = pk2(a0[0], a0[1]); p0.y = pk2(a0[2], a0[3]); p1.x = pk2(a1[0], a1[1]); p1.y = pk2(a1[2], a1[3]);
          *(u32x2*)o0 = p0; *(u32x2*)o1 = p1;
      } }
    __syncthreads();
}

__device__ __forceinline__ void pool_unit(LAS unsigned char* lds, int tok0, const half_t* UP, const bf16* WT, const float* pscale, bf16* MIX, int tid, int lane, int w) {
    LAS float* ul = (LAS float*)lds;
    LAS bf16* act = (LAS bf16*)(lds + 79 * 256 * 4);
    const int ts = tok0 & (SEQ - 1); const size_t rowb = (size_t)(tok0 - ts);
    for (int task = tid; task < 79 * 32; task += NWAVES * 64) {
        const int r = task >> 5, c8 = (task & 31) * 8, tp = ts - 15 + r;
        f32x4 y0 = {0.f, 0.f, 0.f, 0.f}, y1 = y0;
        if (tp >= 0) { const half8 a = *(const half8*)(UP + (rowb + tp) * 256 + c8);
            y0 = (f32x4){(float)a[0], (float)a[1], (float)a[2], (float)a[3]}; y1 = (f32x4){(float)a[4], (float)a[5], (float)a[6], (float)a[7]}; }
        *(LAS f32x4*)(ul + r * 256 + c8) = y0; *(LAS f32x4*)(ul + r * 256 + c8 + 4) = y1;
    }
    __syncthreads();
    { const int c = tid & 255, th = tid >> 8, gi = c >> 6, wlen = 2 << gi;
      for (int q = 0; q < 32; ++q) { const int tt = 32 * th + q, row = tt + 15;
          float s = 0.f;
          for (int i = 0; i < wlen; ++i) s += ul[(row - i) * 256 + c];
          const int cnt = min(ts + tt + 1, wlen);
          const float y = s / (float)cnt - ul[row * 256 + c];
          act[tt * 264 + c] = (bf16)f2bf(y); } }
    __syncthreads();
    { const int r16 = lane & 15, g4 = lane >> 4, gi = w >> 1;
#pragma unroll
      for (int q = 0; q < 2; ++q) { const int dt = 2 * (w & 1) + q;
          f32x4 a[4];
#pragma unroll
          for (int t4 = 0; t4 < 4; ++t4) a[t4] = (f32x4){0.f, 0.f, 0.f, 0.f};
#pragma unroll
          for (int kb = 0; kb < 2; ++kb) {
              const bf16x8 wf = *(const bf16x8*)(WT + (size_t)gi * 4096 + (dt * 16 + r16) * 64 + kb * 32 + 8 * g4);
#pragma unroll
              for (int t4 = 0; t4 < 4; ++t4) { const bf16x8 xf = *(const LAS bf16x8*)(act + (t4 * 16 + r16) * 264 + gi * 64 + kb * 32 + 8 * g4);
                  a[t4] = __builtin_amdgcn_mfma_f32_16x16x32_bf16(wf, xf, a[t4], 0, 0, 0); }
          }
          const int ch = gi * 64 + dt * 16 + 4 * g4;
          const f32x4 sc = *(const f32x4*)(pscale + ch);
#pragma unroll
          for (int t4 = 0; t4 < 4; ++t4) { u32x2 pw; pw.x = pk2(a[t4][0] * sc.x, a[t4][1] * sc.y); pw.y = pk2(a[t4][2] * sc.z, a[t4][3] * sc.w);
              *(u32x2*)(MIX + (size_t)(tok0 + t4 * 16 + r16) * 1024 + 768 + ch) = pw; }
      } }
    __syncthreads();
}

#ifndef EN_T
#define EN_T 1
#endif
#ifndef EN_G
#define EN_G 1
#endif
#ifndef EN_GMASK
#define EN_GMASK 31
#endif
#ifndef DBG_SELECT_ALL
#define DBG_SELECT_ALL 0
#endif
#ifndef EN_ATTN
#define EN_ATTN 1
#endif
#ifndef EN_CONV
#define EN_CONV 1
#endif
#ifndef EN_POOL
#define EN_POOL 1
#endif
struct Args { const float* in[20]; float* out; unsigned char* ws; int ph_lo, ph_hi, li, pad; };
__global__ void __launch_bounds__(NWAVES * 64, 2) fwd(Args args) {
    extern __shared__ __attribute__((aligned(16))) unsigned char lds_raw[];
    LAS unsigned char* lds = (LAS unsigned char*)lds_raw;
    volatile LAS unsigned* MISC = (volatile LAS unsigned*)(lds + MISC_OFF);
    const int tid0 = threadIdx.x;
    const int G = gridDim.x; const int bx = blockIdx.x; const int vcu = (G % 8 == 0) ? (bx % 8) * (G / 8) + bx / 8 : bx;
    unsigned char* ws = args.ws;
    gu32* ctl = (gu32*)(ws + WS_CTL);
    for (int u = tid0; u < (LDS_BYTES - LDSCTL_OFF) / 4; u += NWAVES * 64) ((LAS unsigned*)(lds + LDSCTL_OFF))[u] = 0u;
    __syncthreads();
    XcdBarrier bar = xcd_barrier_post((unsigned*)(ctl + CW_BAR) + args.li * XCD_BAR_WORDS, MISC + 8);
    const int lo = args.ph_lo, hi = args.ph_hi;
#define IN(k) (lo <= (k) && (k) < hi)
#define PHASE_IDS() int tid = threadIdx.x; asm volatile("" : "+v"(tid)); const int lane = tid & 63, wave = __builtin_amdgcn_readfirstlane(tid >> 6); const int gw = vcu * NWAVES + wave; (void)gw; (void)lane
#define SEAM(k) do { if (IN(k) && IN((k) + 1)) xcd_barrier(bar); } while (0)

    const float* x = args.in[0];
    const int NGW = G * NWAVES;

    if (EN_T && IN(0)) {
        int tid = threadIdx.x; asm volatile("" : "+v"(tid));
        float* ROPE0 = (float*)(ws + WS_ROPE);
        const int* pos = (const int*)args.in[2];
        for (int i = vcu * (NWAVES * 64) + tid; i < M * 8; i += G * NWAVES * 64) { const int m = i >> 3, e = i & 7;
            constexpr float invf[8] = {1.0f, 0.1939227432012558f, 0.03760603070259094f, 0.007292664609849453f, 0.0014142135623842478f, 0.00027424818836152554f, 5.318296098266728e-05f, 1.0313386155758053e-05f};
            float iv = invf[0];
#pragma unroll
            for (int k = 1; k < 8; ++k) iv = (e == k) ? invf[k] : iv;
            const float ang = (float)pos[m] * iv; float c, sn; sincos_acc(ang, c, sn);
            ROPE0[(size_t)m * 16 + e] = c; ROPE0[(size_t)m * 16 + 8 + e] = sn; }
    }
    for (int li = 0; li < NLAYER; ++li) {
        const int pb = li * PH_PER_LAYER;
        GAS unsigned char* wsl1 = (GAS unsigned char*)ws; asm volatile("" : "+s"(wsl1)); unsigned char* wsl = (unsigned char*)wsl1;
        GAS float* hres1 = (GAS float*)args.out; asm volatile("" : "+s"(hres1)); float* hres = (float*)hres1;
        int bxl = bx; asm volatile("" : "+s"(bxl));
        bf16* W_IN = (bf16*)(wsl + WS_WIN); bf16* W_OUT = (bf16*)(wsl + WS_WOUT); bf16* W_UP = (bf16*)(wsl + WS_WUP); bf16* W_DN = (bf16*)(wsl + WS_WDN);
        bf16* W_GATE = (bf16*)(wsl + WS_WGATE); bf16* W_PLE = (bf16*)(wsl + WS_WPLE); bf16* W_CPW = (bf16*)(wsl + WS_WCPW); bf16* W_POOL = (bf16*)(wsl + WS_WPOOL);
        float* ROPE = (float*)(wsl + WS_ROPE); bf16* PB = (bf16*)(wsl + WS_P); bf16* XN = (bf16*)(wsl + WS_XN); bf16* YB = (bf16*)(wsl + WS_Y); bf16* HD = (bf16*)(wsl + WS_HD);
        half_t* Qb = (half_t*)(wsl + WS_Q); half_t* QIb = (half_t*)(wsl + WS_QI); half_t* UCb = (half_t*)(wsl + WS_UC); half_t* UPb = (half_t*)(wsl + WS_UP);
        half_t* KBb = (half_t*)(wsl + WS_KB); half_t* VTb = (half_t*)(wsl + WS_VT); v4u* KIb = (v4u*)(wsl + WS_KI); float* WIb = (float*)(wsl + WS_WI); bf16* MIX = (bf16*)(wsl + WS_MIX);
        if (EN_T && IN(pb + 0)) {
            PHASE_IDS();
            _Pragma("unroll 1") for (int rep_ = 0; rep_ < REP_T0; ++rep_) {
            LAS float* scr = (LAS float*)(lds + wave * 16384);
            const float* w_in = args.in[4] + (size_t)li * DM * 2640; const float* w_out = args.in[12] + (size_t)li * DM * DM; const float* w_up = args.in[15] + (size_t)li * DM * FF;
            const float* w_dn = args.in[16] + (size_t)li * FF * DM; const float* w_gate = args.in[19] + (size_t)li * DM * DM; const float* w_ple = args.in[18] + (size_t)li * PLE_DIM * DM;
            const float* w_cpw = args.in[9] + (size_t)li * 256 * 256; const float* w_pool = args.in[10] + (size_t)li * 4 * 64 * 64;
            constexpr int I_IN = 16 * 88, I_OUT = 16 * 32, I_UP = 16 * 128, I_DN = 64 * 32, I_GATE = 16 * 32, I_PLE = 4 * 32, I_CPW = 4 * 8, I_POOL = 8;
            constexpr int NITEMS = I_IN + I_OUT + I_UP + I_DN + I_GATE + I_PLE + I_CPW + I_POOL;
            for (int it = gw; it < NITEMS; it += NGW) {
                int r = it;
                if (r < I_IN) { const int kb = r / 88, db = r % 88; int scol, nv;
                    if (db < 56) { scol = 32 * db; nv = 32; } else if (db < 80) { scol = 1872 + 32 * (db - 56); nv = 32; } else if (db < 82) { scol = 1792 + 32 * (db - 80); nv = 32; }
                    else if (db == 82) { scol = 1856; nv = 16; } else { scol = 0; nv = 0; }
                    tr_item(w_in, DM, 2640, scol, nv, W_IN, 32 * db, 64 * kb, scr, lane); continue; } r -= I_IN;
                if (r < I_OUT) { tr_item(w_out, DM, DM, 32 * (r % 32), 32, W_OUT, 32 * (r % 32), 64 * (r / 32), scr, lane); continue; } r -= I_OUT;
                if (r < I_UP) { tr_item(w_up, DM, FF, 32 * (r % 128), 32, W_UP, 32 * (r % 128), 64 * (r / 128), scr, lane); continue; } r -= I_UP;
                if (r < I_DN) { tr_item(w_dn, FF, DM, 32 * (r % 32), 32, W_DN, 32 * (r % 32), 64 * (r / 32), scr, lane); continue; } r -= I_DN;
                if (r < I_GATE) { tr_item(w_gate, DM, DM, 32 * (r % 32), 32, W_GATE, 32 * (r % 32), 64 * (r / 32), scr, lane); continue; } r -= I_GATE;
                if (r < I_PLE) { tr_item(w_ple, PLE_DIM, DM, 32 * (r % 32), 32, W_PLE, 32 * (r % 32), 64 * (r / 32), scr, lane); continue; } r -= I_PLE;
                if (r < I_CPW) { tr_item(w_cpw, 256, 256, 32 * (r % 8), 32, W_CPW, 32 * (r % 8), 64 * (r / 8), scr, lane); continue; } r -= I_CPW;
                { const int gi = r >> 1; tr_item(w_pool + gi * 4096, 64, 64, 32 * (r & 1), 32, W_POOL + gi * 4096, 32 * (r & 1), 0, scr, lane); }
            }
            const float* pin = args.in[1] + (size_t)li * M * PLE_DIM;
            for (int m = gw; m < M; m += NGW) { const f32x4 v = ((const f32x4*)(pin + (size_t)m * PLE_DIM))[lane];
                ((unsigned long long*)(PB + (size_t)m * PLE_DIM))[lane] = (unsigned long long)pk2(v.x, v.y) | ((unsigned long long)pk2(v.z, v.w) << 32); }
            const float* g0 = args.in[3] + (size_t)li * DM;
            for (int m = gw; m < M; m += NGW) t0_row((li == 0 ? x : hres) + (size_t)m * DM, li == 0 ? hres + (size_t)m * DM : nullptr, g0, XN + (size_t)m * DM, lane);
        }
        }
        SEAM(pb + 0);
        if (EN_G && (EN_GMASK & 1) && IN(pb + 1)) {
            _Pragma("unroll 1") for (int rep_ = 0; rep_ < REP_G1; ++rep_) { pg8::Gemm g{XN, W_IN, M, NIN, DM}; pg8::StaticOrder S; S.init(M, NIN, G, bxl);
            pg8::EpiIn E{Qb, KBb, VTb, QIb, (pg8::u32x4*)KIb, WIb, UCb, UPb, ROPE, QSCALE};
            pg8::gemm_phase<pg8::EpiIn, pg8::StaticOrder, true, true>(lds, g, S, E); }
        }
        SEAM(pb + 1);
        if (IN(pb + 2)) {
            PHASE_IDS();
            const int b = vcu >> 5, s = vcu & 31;
#pragma unroll 1
            for (int i0 = 0; i0 < (EN_ATTN ? 2 * REP_ATTN : 0); ++i0) { const int ut = (i0 & 1) ? 63 - s : s;
                attn_unit(lds, b, ut, Qb, (const v4u*)KBb, (const v4u*)VTb, QIb, KIb, WIb, MIX, tid, lane, wave); }
            const float* cdw = args.in[5] + (size_t)li * 31 * 256; const float* cbi = args.in[6] + (size_t)li * 256; const float* clg = args.in[7] + (size_t)li * 256; const float* clb = args.in[8] + (size_t)li * 256;
#pragma unroll 1
            for (int i = 0; i < (EN_CONV ? 2 * REP_CONV : 0); ++i) conv_unit(lds, vcu * 64 + 32 * (i & 1), UCb, cdw, cbi, clg, clb, W_CPW, MIX, tid, lane, wave);
#pragma unroll 1
            for (int i = 0; i < (EN_POOL ? REP_POOL : 0); ++i) pool_unit(lds, vcu * 64, UPb, W_POOL, args.in[11] + (size_t)li * 256, MIX, tid, lane, wave);
            if (!EN_ATTN || !EN_CONV || !EN_POOL) {
                for (int m = vcu * 64 + wave * 8; m < vcu * 64 + wave * 8 + 8; ++m) {
                    unsigned long long* rowp = (unsigned long long*)(MIX + (size_t)m * 1024);
                    for (int j = 0; j < 4; ++j) { const int piece = lane + 64 * j; const int colx = piece * 4;
                        const bool z = (colx < 512) ? !EN_ATTN : (colx < 768) ? !EN_CONV : !EN_POOL;
                        if (z) rowp[piece] = 0ull; } }
            }
        }
        SEAM(pb + 2);
        if (EN_G && (EN_GMASK & 2) && IN(pb + 3)) {
            _Pragma("unroll 1") for (int rep_ = 0; rep_ < REP_G2; ++rep_) { pg8::Gemm g{MIX, W_OUT, M, DM, DM}; pg8::StaticOrder S; S.init(M, DM, G, bxl);
            pg8::EpiBf16<0> E{YB, DM};
            pg8::gemm_phase<pg8::EpiBf16<0>, pg8::StaticOrder, false, true>(lds, g, S, E); }
        }
        SEAM(pb + 3);
        if (EN_T && IN(pb + 4)) {
            PHASE_IDS();
            const float* gp = args.in[13] + (size_t)li * DM; const float* gn = args.in[14] + (size_t)li * DM;
            for (int m = gw; m < M; m += NGW) tres_row(YB + (size_t)m * DM, gp, hres + (size_t)m * DM, gn, XN + (size_t)m * DM, lane);
        }
        SEAM(pb + 4);
        if (EN_G && (EN_GMASK & 4) && IN(pb + 5)) {
            _Pragma("unroll 1") for (int rep_ = 0; rep_ < REP_G3; ++rep_) { pg8::Gemm g{XN, W_UP, M, FF, DM}; pg8::StaticOrder S; S.init(M, FF, G, bxl);
            pg8::EpiBf16<1> E{HD, FF};
            pg8::gemm_phase<pg8::EpiBf16<1>, pg8::StaticOrder, true, true>(lds, g, S, E); }
        }
        SEAM(pb + 5);
        if (EN_G && (EN_GMASK & 8) && IN(pb + 6)) {
            _Pragma("unroll 1") for (int rep_ = 0; rep_ < REP_G4; ++rep_) { pg8::Gemm g{HD, W_DN, M, DM, FF}; pg8::StaticOrder S; S.init(M, DM, G, bxl);
            pg8::EpiBf16<0> E{YB, DM};
            pg8::gemm_phase<pg8::EpiBf16<0>, pg8::StaticOrder, false, true>(lds, g, S, E); }
        }
        SEAM(pb + 6);
        if (EN_T && IN(pb + 7)) {
            PHASE_IDS();
            const float* gp = args.in[17] + (size_t)li * DM;
            for (int m = gw; m < M; m += NGW) tres_row(YB + (size_t)m * DM, gp, hres + (size_t)m * DM, nullptr, XN + (size_t)m * DM, lane);
        }
        SEAM(pb + 7);
        if (EN_G && (EN_GMASK & 16) && IN(pb + 8)) {
            { pg8::Gemm g{PB, W_PLE, M, DM, PLE_DIM}; pg8::StaticOrder S; S.init(M, DM, G, bxl);
              pg8::EpiBf16<0> E{YB, DM};
              pg8::gemm_phase<pg8::EpiBf16<0>, pg8::StaticOrder, false, true>(lds, g, S, E); }
            VM_WAIT(); __syncthreads();
            { pg8::Gemm g{XN, W_GATE, M, DM, DM}; pg8::StaticOrder S; S.init(M, DM, G, bxl);
              pg8::EpiGate E{hres, YB};
              pg8::gemm_phase<pg8::EpiGate, pg8::StaticOrder, false, true>(lds, g, S, E); }
        }
        SEAM(pb + 8);
    }
#undef IN
#undef SEAM
}

extern "C" void kernel_launch(void* const* d_in, const int* in_sizes, int n_in, void* d_out, int out_size, void* d_ws, size_t ws_size, hipStream_t stream) {
    static int grid = 0;
    if (grid == 0) {
        if (n_in != 20 || in_sizes[0] != M * DM || out_size != M * DM || ws_size < WS_END) { fprintf(stderr, "kernel_launch: unexpected shapes (n_in %d, in0 %d, out %d, ws %zu); nothing launched\n", n_in, n_in > 0 ? in_sizes[0] : -1, out_size, ws_size); grid = -1; return; }
        int dev = 0, cus = 0, per_cu = 0;
        if (hipGetDevice(&dev) != hipSuccess || hipDeviceGetAttribute(&cus, hipDeviceAttributeMultiprocessorCount, dev) != hipSuccess) { grid = -1; return; }
        if (hipFuncSetAttribute((const void*)fwd, hipFuncAttributeMaxDynamicSharedMemorySize, LDS_BYTES) != hipSuccess) { fprintf(stderr, "kernel_launch: hipFuncSetAttribute failed\n"); grid = -1; return; }
        if (hipOccupancyMaxActiveBlocksPerMultiprocessor(&per_cu, (const void*)fwd, NWAVES * 64, LDS_BYTES) != hipSuccess || per_cu < 1) fprintf(stderr, "kernel_launch: occupancy query reports %d workgroups per CU\n", per_cu);
        (void)hipGetLastError();
        grid = 256;
        if (cus < 256) { fprintf(stderr, "kernel_launch: %d CUs < 256; nothing launched\n", cus); grid = -1; return; }
    }
    if (grid < 0) return;
    if (hipMemsetAsync((char*)d_ws + WS_CTL, 0, CTL_ZERO_BYTES, stream) != hipSuccess) return;
    Args a{};
    for (int i = 0; i < 20; ++i) a.in[i] = (const float*)d_in[i];
    a.out = (float*)d_out; a.ws = (unsigned char*)d_ws; a.pad = 0;
    for (int li = 0; li < N_LAUNCHES; ++li) {
        if (N_LAUNCHES == 1) { a.ph_lo = 0; a.ph_hi = NPHASE; } else { a.ph_lo = li * (NPHASE / N_LAUNCHES); a.ph_hi = (li + 1) * (NPHASE / N_LAUNCHES); }
        a.li = li;
        hipLaunchKernelGGL(fwd, dim3(grid), dim3(NWAVES * 64), LDS_BYTES, stream, a);
        if (hipPeekAtLastError() != hipSuccess) { fprintf(stderr, "kernel_launch: launch %d failed\n", li); break; }
    }
}
```
